# Optimizing an MI355X kernel written in HIP

```python
import jax, jax.numpy as jnp
from jax import lax
import numpy as np

D_MODEL = 1024
BATCH = 4
SEQ = 4096
DEPTH = 1
DEC_BATCH = 128
DEC_SEQ = 8
PAST_LEN = 16384
PAGE_SIZE = 128

N_HEADS = 8
N_KV_HEADS = 2
HEAD_DIM = 64
GQA_GROUP = N_HEADS // N_KV_HEADS
WINDOW = 128
ATTN_WIDTH = N_HEADS * HEAD_DIM
KV_WIDTH = N_KV_HEADS * HEAD_DIM
SCALE = HEAD_DIM ** -0.5
HG_HEADS = 4
HG_DK = 128
HG_DV = 128
HG_KEY_WIDTH = HG_HEADS * HG_DK
HG_WIDTH = HG_HEADS * HG_DV
HG_CHUNK = 64
MIX_WIDTH = ATTN_WIDTH + HG_WIDTH
IN_SPLITS = [ATTN_WIDTH, KV_WIDTH, KV_WIDTH, HG_KEY_WIDTH, HG_KEY_WIDTH, HG_WIDTH, HG_WIDTH]
IN_WIDTH = sum(IN_SPLITS)
D_FF = 2816
EPS = 1e-6

kernel_name = "hymba_swa_sink_hgrn2_macaron_step"


def rms_norm(x, g):
    xf = x.astype(jnp.float32)
    y = xf * lax.rsqrt(jnp.mean(xf * xf, axis=-1, keepdims=True) + EPS)
    return (y * g.astype(jnp.float32)).astype(x.dtype)


def swiglu(x, w_gu, w_down):
    g, u = jnp.split(x @ w_gu, 2, axis=-1)
    return (jax.nn.silu(g) * u) @ w_down


def sink_probs(s, mask, sink):
    s = jnp.where(mask, s, -jnp.inf)
    sk = sink.astype(jnp.float32)[..., None, None]
    m = jnp.maximum(jnp.max(s, axis=-1, keepdims=True), sk)
    p = jnp.exp(s - m)
    den = jnp.sum(p, axis=-1, keepdims=True) + jnp.exp(sk - m)
    return p / den


def banded_window_attention(q, k, v, sinks):
    B, L = q.shape[:2]
    W = WINDOW
    nb = L // W
    qb = q.reshape(B, nb, W, N_KV_HEADS, GQA_GROUP, HEAD_DIM).astype(jnp.float32)

    def with_prev(a):
        a = a.reshape(B, nb, W, N_KV_HEADS, HEAD_DIM).astype(jnp.float32)
        prev = jnp.pad(a, ((0, 0), (1, 0), (0, 0), (0, 0), (0, 0)))[:, :-1]
        return jnp.concatenate([prev, a], axis=2)

    kk, vv = with_prev(k), with_prev(v)
    s = jnp.einsum('bnqhgd,bnkhd->bnhgqk', qb, kk) * SCALE
    qi = jnp.arange(W)[:, None]
    kj = jnp.arange(2 * W)[None, :]
    dist = qi + W - kj
    band = (dist >= 0) & (dist <= WINDOW)
    valid = (jnp.arange(nb)[:, None, None] > 0) | (kj >= W)[None]
    mask = band[None] & valid
    p = sink_probs(s, mask[:, None, None], sinks.reshape(N_KV_HEADS, GQA_GROUP))
    out = jnp.einsum('bnhgqk,bnkhd->bnqhgd', p, vv)
    keep = min(WINDOW, L)
    return out.reshape(B, L, ATTN_WIDTH).astype(q.dtype), k[:, L - keep:], v[:, L - keep:]


def cached_window_attention(q, k, v, sinks, k_buf, v_buf):
    Bd, Ld = q.shape[:2]
    Wb = k_buf.shape[1]
    kk = jnp.concatenate([k_buf.astype(k.dtype), k], axis=1)
    vv = jnp.concatenate([v_buf.astype(v.dtype), v], axis=1)
    s = jnp.einsum('bqhgd,bkhd->bhgqk', q.astype(jnp.float32), kk.astype(jnp.float32)) * SCALE
    dist = (Wb + jnp.arange(Ld))[:, None] - jnp.arange(Wb + Ld)[None, :]
    mask = (dist >= 0) & (dist <= WINDOW)
    p = sink_probs(s, mask, sinks.reshape(N_KV_HEADS, GQA_GROUP))
    out = jnp.einsum('bhgqk,bkhd->bqhgd', p, vv.astype(jnp.float32))
    return out.reshape(Bd, Ld, ATTN_WIDTH).astype(q.dtype), kk[:, Ld:], vv[:, Ld:]


def hgrn2_chunked(q, k, logf, v, s0):
    B, L = q.shape[:2]
    C = min(HG_CHUNK, L)
    n = -(-L // C)
    pad = n * C - L

    def prep(a):
        a = jnp.pad(a, ((0, 0), (0, pad), (0, 0), (0, 0)))
        return a.reshape(B, n, C, a.shape[2], a.shape[3]).transpose(1, 0, 3, 2, 4)

    qc, kc, gc, vc = prep(q), prep(k), prep(logf), prep(v)
    causal = jnp.tril(jnp.ones((C, C), dtype=bool))[:, :, None]

    def step(S, inp):
        qb, kb, gb, vb = inp
        G = jnp.cumsum(gb, axis=2)
        diff = G[:, :, :, None, :] - G[:, :, None, :, :]
        decay = jnp.exp(jnp.where(causal, diff, -jnp.inf))
        A = jnp.einsum('bhtk,bhsk,bhtsk->bhts', qb, kb, decay)
        o = jnp.einsum('bhts,bhsv->bhtv', A, vb) + jnp.einsum('bhtk,bhkv->bhtv', qb * jnp.exp(G), S)
        G_last = G[:, :, -1:, :]
        S = jnp.exp(G_last[:, :, 0, :])[..., None] * S + jnp.einsum(
            'bhsk,bhsv->bhkv', kb * jnp.exp(G_last - G), vb)
        return S, o

    S, o = lax.scan(step, s0, (qc, kc, gc, vc))
    o = o.transpose(1, 0, 3, 2, 4).reshape(B, n * C, q.shape[2], v.shape[3])[:, :L]
    return o, S


def setup_inputs(seed: int = 0) -> dict:
    key = jax.random.key(seed)
    ks = jax.random.split(key, 24)
    f32 = jnp.float32
    win_buf = min(WINDOW, PAST_LEN)

    def nrm(k, shape, scale):
        return jax.random.normal(k, shape, f32) * scale

    def gain(k, shape):
        return 1.0 + 0.02 * jax.random.normal(k, shape, f32)

    return {
        "x_prompt": nrm(ks[0], (BATCH, SEQ, D_MODEL), 1.0),
        "x_sample": nrm(ks[1], (DEC_BATCH, DEC_SEQ, D_MODEL), 1.0),
        "cache_k_win": nrm(ks[2], (DEPTH, DEC_BATCH, win_buf, N_KV_HEADS, HEAD_DIM), 1.0),
        "cache_v_win": nrm(ks[3], (DEPTH, DEC_BATCH, win_buf, N_KV_HEADS, HEAD_DIM), 1.0),
        "state_hgrn": nrm(ks[4], (DEPTH, DEC_BATCH, HG_HEADS, HG_DK, HG_DV), 0.5),
        "w_in": nrm(ks[5], (DEPTH, D_MODEL, IN_WIDTH), D_MODEL ** -0.5),
        "b_in": nrm(ks[6], (DEPTH, IN_WIDTH), 0.02),
        "attn_sinks": nrm(ks[7], (DEPTH, N_HEADS), 0.5),
        "attn_out_norm": gain(ks[8], (DEPTH, ATTN_WIDTH)),
        "hg_lb_logits": nrm(ks[9], (DEPTH + 1, HG_KEY_WIDTH), 0.1),
        "hg_out_norm": gain(ks[10], (DEPTH, HG_DV)),
        "w_out": nrm(ks[11], (DEPTH, MIX_WIDTH, D_MODEL), MIX_WIDTH ** -0.5),
        "ffn1_w_gu": nrm(ks[12], (DEPTH, D_MODEL, 2 * D_FF), D_MODEL ** -0.5),
        "ffn1_w_down": nrm(ks[13], (DEPTH, D_FF, D_MODEL), D_FF ** -0.5),
        "ffn2_w_gu": nrm(ks[14], (DEPTH, D_MODEL, 2 * D_FF), D_MODEL ** -0.5),
        "ffn2_w_down": nrm(ks[15], (DEPTH, D_FF, D_MODEL), D_FF ** -0.5),
        "norm_ffn1_pre": gain(ks[16], (DEPTH, D_MODEL)),
        "norm_ffn1_post": gain(ks[17], (DEPTH, D_MODEL)),
        "norm_mix_pre": gain(ks[18], (DEPTH, D_MODEL)),
        "norm_mix_post": gain(ks[19], (DEPTH, D_MODEL)),
        "norm_ffn2_pre": gain(ks[20], (DEPTH, D_MODEL)),
        "norm_ffn2_post": gain(ks[21], (DEPTH, D_MODEL)),
    }


def reference(x_prompt, x_sample, cache_k_win, cache_v_win, state_hgrn,
              w_in, b_in, attn_sinks, attn_out_norm, hg_lb_logits, hg_out_norm, w_out,
              ffn1_w_gu, ffn1_w_down, ffn2_w_gu, ffn2_w_down,
              norm_ffn1_pre, norm_ffn1_post, norm_mix_pre, norm_mix_post,
              norm_ffn2_pre, norm_ffn2_post):
    f32 = jnp.float32
    lb_all = jnp.cumsum(jax.nn.softmax(hg_lb_logits.astype(f32), axis=0), axis=0)

    def run_layer(x, l, attend, s0):
        B, L = x.shape[:2]
        x = x + 0.5 * rms_norm(swiglu(rms_norm(x, norm_ffn1_pre[l]), ffn1_w_gu[l], ffn1_w_down[l]),
                               norm_ffn1_post[l])
        h = rms_norm(x, norm_mix_pre[l])
        z = h @ w_in[l] + b_in[l]
        q, k, v, hq, hf, hi, hg = jnp.split(z, [int(c) for c in np.cumsum(IN_SPLITS)[:-1]], axis=-1)
        q = q.reshape(B, L, N_KV_HEADS, GQA_GROUP, HEAD_DIM)
        k = k.reshape(B, L, N_KV_HEADS, HEAD_DIM)
        v = v.reshape(B, L, N_KV_HEADS, HEAD_DIM)
        a, k_new, v_new = attend(q, k, v, attn_sinks[l])
        a = rms_norm(a, attn_out_norm[l])
        lb = lb_all[l].reshape(HG_HEADS, HG_DK)
        hq = jax.nn.silu(hq.reshape(B, L, HG_HEADS, HG_DK).astype(f32))
        f = lb + (1.0 - lb) * jax.nn.sigmoid(hf.reshape(B, L, HG_HEADS, HG_DK).astype(f32))
        o, S = hgrn2_chunked(hq, 1.0 - f, jnp.log(f),
                             hi.reshape(B, L, HG_HEADS, HG_DV).astype(f32), s0)
        o = rms_norm(o, hg_out_norm[l]) * jax.nn.silu(hg.reshape(B, L, HG_HEADS, HG_DV).astype(f32))
        o = o.reshape(B, L, HG_WIDTH).astype(x.dtype)
        mix = jnp.concatenate([a, o], axis=-1) @ w_out[l]
        x = x + rms_norm(mix, norm_mix_post[l])
        x = x + 0.5 * rms_norm(swiglu(rms_norm(x, norm_ffn2_pre[l]), ffn2_w_gu[l], ffn2_w_down[l]),
                               norm_ffn2_post[l])
        return x, k_new, v_new, S

    yp, ys = x_prompt, x_sample
    kp, vp, sp, kd, vd, sd = [], [], [], [], [], []
    for l in range(DEPTH):
        s0p = jnp.zeros((x_prompt.shape[0], HG_HEADS, HG_DK, HG_DV), f32)
        yp, k1, v1, s1 = run_layer(yp, l, banded_window_attention, s0p)
        kp.append(k1); vp.append(v1); sp.append(s1)

        def attend_cached(q, k, v, sinks, l=l):
            return cached_window_attention(q, k, v, sinks, cache_k_win[l], cache_v_win[l])

        ys, k2, v2, s2 = run_layer(ys, l, attend_cached, state_hgrn[l].astype(f32))
        kd.append(k2); vd.append(v2); sd.append(s2)

    return (yp, ys, jnp.stack(kp), jnp.stack(vp), jnp.stack(sp), jnp.stack(kd), jnp.stack(vd), jnp.stack(sd))
```

```cpp
#include <hip/hip_runtime.h>
#include <cstdio>
#include <cstdint>
namespace pg8 {
#define PG8_LAS __attribute__((address_space(3)))
typedef unsigned short bf16_t;
typedef short bf16x8 __attribute__((ext_vector_type(8)));
typedef float f32x4 __attribute__((ext_vector_type(4)));
typedef unsigned u32x4 __attribute__((ext_vector_type(4)));
constexpr int BM = 256, BK = 64, HALF = 128, HTB = HALF * BK * 2  , STAGE_BYTES = 8 * HTB, NXCD = 8, WGM = 8;

__host__ __device__ __forceinline__ int lds_byte(int r, int c) { const int st = (r >> 4) * 2 + (c >> 5), rr = r & 15, cc = c & 31, ob = rr * 64 + cc * 2; return st * 1024 + (ob ^ (((ob >> 9) & 1) << 5)); }
__host__ __device__ __forceinline__ void stage_rc(int b, int& R, int& C) { const int st = b / 1024, sb = b % 1024, swz = sb ^ (((sb >> 9) & 1) << 5); R = (st >> 1) * 16 + swz / 64; C = (st & 1) * 32 + (swz % 64) / 2; }
__host__ __device__ __forceinline__ int perm32(int rho) { const int n = rho >> 4, i = rho & 15; return 8 * (i >> 2) + 4 * n + (i & 3); }

struct Unit { int pm, pn; };
struct Gemm { const bf16_t* A; const bf16_t* Bt; int M, N, K; };

struct StaticOrder {
    int nM, nN, nwg, G, c;
    __host__ __device__ void init(int M, int N, int G_, int c_) { nM = M / BM; nN = N / BM; nwg = nM * nN; G = G_; c = c_; }
    __host__ __device__ bool next(int i, Unit& u) const {
        const long L = (long)i * G + c; if (L >= nwg) return false;
        int wgid = (int)L; { const int q = nwg / NXCD, r = nwg % NXCD, xcd = wgid % NXCD, off = wgid / NXCD; wgid = (xcd < r ? xcd * (q + 1) : r * (q + 1) + (xcd - r) * q) + off; }
        const int nig = WGM * nN, gid = wgid / nig, fm = gid * WGM, gsz = (nM - fm) < WGM ? (nM - fm) : WGM;
        u.pm = fm + ((wgid % nig) % gsz); u.pn = (wgid % nig) / gsz; return true;
    }
    __device__ __forceinline__ void a_ready(const Unit&) const {}
    __device__ __forceinline__ void done(const Unit&) const {}
};

__device__ __forceinline__ unsigned cvt_pk_bf16(float lo, float hi) { unsigned r; asm volatile("v_cvt_pk_bf16_f32 %0, %1, %2" : "=v"(r) : "v"(lo), "v"(hi)); return r; }
typedef float f32x2 __attribute__((ext_vector_type(2)));
__device__ __forceinline__ f32x2 gelu_pk(f32x2 v) {
    const f32x2 av = __builtin_elementwise_abs(v), d = av * 0.2316418882f + 1.0f;
    f32x2 t; t.x = __builtin_amdgcn_rcpf(d.x); t.y = __builtin_amdgcn_rcpf(d.y);
    f32x2 q = t * 0.5307027145f + (-0.7265760135f); q = q * t + 0.7107068705f; q = q * t + (-0.142248368f); q = q * t + 0.127414796f; q = q * t;
    const f32x2 s = (v * v) * (-0.72134752044f);
    f32x2 e; e.x = __builtin_amdgcn_exp2f(s.x); e.y = __builtin_amdgcn_exp2f(s.y);
    const f32x2 m = v * (q * e), r = v - m;
    f32x2 o; o.x = v.x < 0.f ? m.x : r.x; o.y = v.y < 0.f ? m.y : r.y; return o;
}

template <int ACT  > struct EpiBf16 {
    static constexpr bool PERM = true, AFTER_DRAIN = false; static_assert(ACT == 0 || ACT == 1, "EpiBf16: ACT is 0 (none) or 1 (gelu_pk)");
    bf16_t* O; int ldc; const float* bias; int split_cols; size_t split_stride; float scale0;
    __device__ __forceinline__ void operator()(const f32x4 (&acc)[2][2][4][2], const Unit& u, int wr, int wc, int fr, int fq) const {
        const int row0 = u.pm * BM + wr * 64 + fr; int colt = u.pn * BM; bf16_t* base = O;
        float sc = 1.f; if (split_cols) { const int t = colt / split_cols; base += (size_t)t * split_stride; colt -= t * split_cols; if (t == 0) sc = scale0; }
        const int col0 = colt + wc * 32 + 8 * fq, bcol0 = u.pn * BM + wc * 32 + 8 * fq;
        f32x4 bv[2][2];
#pragma unroll
        for (int bj = 0; bj < 2; ++bj)
#pragma unroll
            for (int n = 0; n < 2; ++n) bv[bj][n] = bias ? *(const f32x4*)(bias + bcol0 + bj * HALF + 4 * n) : (f32x4){0.f, 0.f, 0.f, 0.f};
#pragma unroll
        for (int ai = 0; ai < 2; ++ai)
#pragma unroll
            for (int m = 0; m < 4; ++m) { bf16_t* rowp = base + (size_t)(row0 + ai * HALF + m * 16) * ldc + col0;
#pragma unroll
                for (int bj = 0; bj < 2; ++bj) { f32x4 v0 = acc[ai][bj][m][0] + bv[bj][0], v1 = acc[ai][bj][m][1] + bv[bj][1];
                    if (ACT == 1) { f32x2 a = gelu_pk((f32x2){v0[0], v0[1]}), b = gelu_pk((f32x2){v0[2], v0[3]}), c = gelu_pk((f32x2){v1[0], v1[1]}), d = gelu_pk((f32x2){v1[2], v1[3]});
                        v0 = (f32x4){a.x, a.y, b.x, b.y}; v1 = (f32x4){c.x, c.y, d.x, d.y}; }
                    v0 = v0 * sc; v1 = v1 * sc; u32x4 w; w.x = cvt_pk_bf16(v0[0], v0[1]); w.y = cvt_pk_bf16(v0[2], v0[3]); w.z = cvt_pk_bf16(v1[0], v1[1]); w.w = cvt_pk_bf16(v1[2], v1[3]);
                    *(u32x4*)(rowp + bj * HALF) = w; } }
    }
};
template <class Epi, class Sched, bool ALIGN_EPI = false, bool SP2 = false>
__device__ __forceinline__ void gemm_phase(PG8_LAS unsigned char* lds, const Gemm g, const Sched& S, const Epi& E) {
    const int tid = threadIdx.x, wid = __builtin_amdgcn_readfirstlane(tid >> 6), lane = tid & 63, wr = wid >> 2, wc = wid & 3, fr = lane & 15, fq = lane >> 4;
    const int K = g.K, nt = K / BK;
    unsigned voffA[2], voffB[2];
#pragma unroll
    for (int i = 0; i < 2; ++i) { int R, C; stage_rc(tid * 16 + i * 8192, R, C); const int Rb = Epi::PERM ? ((R & ~31) + perm32(R & 31)) : R;
        voffA[i] = (unsigned)(R * K + C) * 2u; voffB[i] = (unsigned)(Rb * K + C) * 2u; }
    const size_t kstep = (size_t)(BK * 2);
    const size_t hstep = (size_t)HALF * K * 2;
    const size_t tstep = 2 * hstep;
    const unsigned ldsw = (unsigned)wid * 1024u;
    const int aoff = lds_byte(wr * 64 + fr, fq * 8), boff = lds_byte(wc * 32 + fr, fq * 8);
#define PG8_SA(b, h) (((b) * 2 + (h)) * HTB)
#define PG8_SB(b, h) ((4 + (b) * 2 + (h)) * HTB)
#define PG8_STAGE(bufoff, gbase, voff) do { _Pragma("unroll") for (int _i = 0; _i < 2; ++_i) \
        __builtin_amdgcn_global_load_lds((const unsigned*)((const char*)(gbase) + (voff)[_i]), (PG8_LAS unsigned*)(lds + (bufoff) + ldsw + _i * 8192), 16, 0, 0); } while (0)
#define PG8_LDA(dst, b, h) do { _Pragma("unroll") for (int m = 0; m < 4; ++m) _Pragma("unroll") for (int k = 0; k < 2; ++k) dst[m][k] = *(const PG8_LAS bf16x8*)(lds + PG8_SA(b, h) + aoff + m * 2048 + k * 1024); } while (0)
#define PG8_LDB(dst, b, h) do { _Pragma("unroll") for (int n = 0; n < 2; ++n) _Pragma("unroll") for (int k = 0; k < 2; ++k) dst[n][k] = *(const PG8_LAS bf16x8*)(lds + PG8_SB(b, h) + boff + n * 2048 + k * 1024); } while (0)
#define PG8_MMA(ai, bj, At, Bt) do { __builtin_amdgcn_s_setprio(1); _Pragma("unroll") for (int m = 0; m < 4; ++m) _Pragma("unroll") for (int n = 0; n < 2; ++n) _Pragma("unroll") for (int k = 0; k < 2; ++k) \
        acc[ai][bj][m][n] = __builtin_amdgcn_mfma_f32_16x16x32_bf16(Bt[n][k], At[m][k], acc[ai][bj][m][n], 0, 0, 0); __builtin_amdgcn_s_setprio(0); } while (0)
#define PG8_WAIT_V(n) asm volatile("s_waitcnt vmcnt(" #n ")" ::: "memory")
#define PG8_WAIT_L(n) asm volatile("s_waitcnt lgkmcnt(" #n ")" ::: "memory")
#define PG8_BAR __builtin_amdgcn_s_barrier()
#define PG8_SCHED __builtin_amdgcn_sched_barrier(0)
    Unit cur, nxt; int ui = 0;
    if (!S.next(0, cur)) return;
    f32x4 acc[2][2][4][2];
#pragma unroll
    for (int a = 0; a < 2; ++a)
#pragma unroll
        for (int b = 0; b < 2; ++b)
#pragma unroll
            for (int m = 0; m < 4; ++m)
#pragma unroll
                for (int n = 0; n < 2; ++n) acc[a][b][m][n] = (f32x4){0.f, 0.f, 0.f, 0.f};
    bf16x8 At[4][2], B0[2][2], B1[2][2];
    const char* cA = (const char*)g.A + (size_t)cur.pm * tstep; const char* cB = (const char*)g.Bt + (size_t)cur.pn * tstep;
    S.a_ready(cur);
    if constexpr (SP2) {
        PG8_STAGE(PG8_SB(0, 0), cB, voffB); PG8_STAGE(PG8_SB(0, 1), cB + hstep, voffB); PG8_STAGE(PG8_SA(0, 0), cA, voffA); PG8_STAGE(PG8_SA(0, 1), cA + hstep, voffA);
        if (wr == 1) PG8_BAR;
        PG8_WAIT_V(2); PG8_BAR;
        PG8_STAGE(PG8_SB(1, 0), cB + kstep, voffB); PG8_STAGE(PG8_SA(1, 0), cA + kstep, voffA); PG8_STAGE(PG8_SB(1, 1), cB + hstep + kstep, voffB);
        PG8_WAIT_V(6); PG8_BAR;
    } else {
        PG8_STAGE(PG8_SB(0, 0), cB, voffB); PG8_STAGE(PG8_SA(0, 0), cA, voffA); PG8_STAGE(PG8_SB(0, 1), cB + hstep, voffB); PG8_STAGE(PG8_SA(0, 1), cA + hstep, voffA);
        if (wr == 1) PG8_BAR;
        PG8_WAIT_V(4); PG8_BAR;
        PG8_STAGE(PG8_SB(1, 0), cB + kstep, voffB); PG8_STAGE(PG8_SA(1, 0), cA + kstep, voffA); PG8_STAGE(PG8_SB(1, 1), cB + hstep + kstep, voffB);
        PG8_WAIT_V(6); PG8_BAR;
    }
    for (;;) {
        const bool has_next = S.next(ui + 1, nxt);
        const char* nA = has_next ? (const char*)g.A + (size_t)nxt.pm * tstep : cA; const char* nB = has_next ? (const char*)g.Bt + (size_t)nxt.pn * tstep : cB;
        for (int t = 0; t < nt; t += 2) {
            const bool last = (t == nt - 2);
            const char* a1 = cA + (size_t)(t + 1) * kstep;
            const char* a2 = last ? nA : cA + (size_t)(t + 2) * kstep; const char* b2 = last ? nB : cB + (size_t)(t + 2) * kstep;
            const char* a3 = a2 + kstep; const char* b3 = b2 + kstep;
            if (last && has_next) S.a_ready(nxt);
            if constexpr (SP2) {
            PG8_LDB(B0, 0, 0); PG8_LDB(B1, 0, 1); PG8_SCHED; PG8_LDA(At, 0, 0); PG8_STAGE(PG8_SA(1, 1), a1 + hstep, voffA);
            PG8_WAIT_V(8); PG8_WAIT_L(0); PG8_BAR; PG8_MMA(0, 0, At, B0); PG8_MMA(0, 1, At, B1); PG8_BAR; PG8_SCHED;
            PG8_LDA(At, 0, 1); PG8_STAGE(PG8_SB(0, 0), b2, voffB); PG8_STAGE(PG8_SB(0, 1), b2 + hstep, voffB); PG8_STAGE(PG8_SA(0, 0), a2, voffA);
            PG8_WAIT_V(8); PG8_WAIT_L(0); PG8_BAR; PG8_MMA(1, 0, At, B0); PG8_MMA(1, 1, At, B1); PG8_BAR; PG8_SCHED;
            PG8_LDB(B0, 1, 0); PG8_LDB(B1, 1, 1); PG8_SCHED; PG8_LDA(At, 1, 0); PG8_STAGE(PG8_SA(0, 1), a2 + hstep, voffA);
            PG8_WAIT_V(8); PG8_WAIT_L(0); PG8_BAR; PG8_MMA(0, 0, At, B0); PG8_MMA(0, 1, At, B1); PG8_BAR; PG8_SCHED;
            PG8_LDA(At, 1, 1); PG8_STAGE(PG8_SB(1, 0), b3, voffB); PG8_STAGE(PG8_SB(1, 1), b3 + hstep, voffB); PG8_STAGE(PG8_SA(1, 0), a3, voffA);
            PG8_WAIT_V(8); PG8_WAIT_L(0); PG8_BAR; PG8_MMA(1, 0, At, B0); PG8_MMA(1, 1, At, B1); PG8_BAR; PG8_SCHED;
            } else {
            PG8_LDB(B0, 0, 0); PG8_SCHED; PG8_LDA(At, 0, 0); PG8_STAGE(PG8_SA(1, 1), a1 + hstep, voffA);
            PG8_WAIT_L(8); PG8_BAR; PG8_WAIT_L(0); PG8_MMA(0, 0, At, B0); PG8_BAR; PG8_SCHED;
            PG8_LDB(B1, 0, 1); PG8_STAGE(PG8_SB(0, 0), b2, voffB);
            PG8_BAR; PG8_WAIT_L(0); PG8_MMA(0, 1, At, B1); PG8_BAR;
            PG8_LDA(At, 0, 1); PG8_STAGE(PG8_SA(0, 0), a2, voffA);
            PG8_BAR; PG8_WAIT_L(0); PG8_MMA(1, 0, At, B0); PG8_BAR; PG8_SCHED;
            PG8_STAGE(PG8_SB(0, 1), b2 + hstep, voffB);
            PG8_WAIT_V(6); PG8_BAR; PG8_MMA(1, 1, At, B1); PG8_BAR;
            PG8_LDB(B0, 1, 0); PG8_SCHED; PG8_LDA(At, 1, 0); PG8_STAGE(PG8_SA(0, 1), a2 + hstep, voffA);
            PG8_WAIT_L(8); PG8_BAR; PG8_WAIT_L(0); PG8_MMA(0, 0, At, B0); PG8_BAR; PG8_SCHED;
            PG8_LDB(B1, 1, 1); PG8_STAGE(PG8_SB(1, 0), b3, voffB);
            PG8_BAR; PG8_WAIT_L(0); PG8_MMA(0, 1, At, B1); PG8_BAR;
            PG8_LDA(At, 1, 1); PG8_STAGE(PG8_SA(1, 0), a3, voffA);
            PG8_BAR; PG8_WAIT_L(0); PG8_MMA(1, 0, At, B0); PG8_BAR; PG8_SCHED;
            PG8_STAGE(PG8_SB(1, 1), b3 + hstep, voffB);
            PG8_WAIT_V(6); PG8_BAR; PG8_MMA(1, 1, At, B1); PG8_BAR;
            }
        }
        if constexpr (ALIGN_EPI) { if (wr == 0) PG8_BAR; }
        if constexpr (!Epi::AFTER_DRAIN) { E(acc, cur, wr, wc, fr, fq); S.done(cur); }
        if (!has_next) break;
#pragma unroll
        for (int a = 0; a < 2; ++a)
#pragma unroll
            for (int b = 0; b < 2; ++b)
#pragma unroll
                for (int m = 0; m < 4; ++m)
#pragma unroll
                    for (int n = 0; n < 2; ++n) acc[a][b][m][n] = (f32x4){0.f, 0.f, 0.f, 0.f};
        cur = nxt; cA = nA; cB = nB; ++ui;
        if constexpr (ALIGN_EPI) { if (wr == 1) PG8_BAR; }
    }
    PG8_WAIT_V(0);
    if constexpr (!ALIGN_EPI) { if (wr == 0) PG8_BAR; }
    PG8_BAR;
    if constexpr (Epi::AFTER_DRAIN) { E.fused(acc, cur, wr, wc, fr, fq, lds, wid, lane); S.done(cur); }
#undef PG8_SA
#undef PG8_SB
#undef PG8_STAGE
#undef PG8_LDA
#undef PG8_LDB
#undef PG8_MMA
#undef PG8_WAIT_V
#undef PG8_WAIT_L
#undef PG8_BAR
#undef PG8_SCHED
}
}

#include <hip/hip_cooperative_groups.h>
namespace cg = cooperative_groups;

#define GAS __attribute__((address_space(1)))
#define LAS __attribute__((address_space(3)))
typedef unsigned short bf16;
typedef unsigned v4u __attribute__((ext_vector_type(4)));
typedef unsigned v2u __attribute__((ext_vector_type(2)));
typedef float f32x4 __attribute__((ext_vector_type(4)));
typedef float f32x2 __attribute__((ext_vector_type(2)));
typedef float f32x16 __attribute__((ext_vector_type(16)));
typedef short bf16x8 __attribute__((ext_vector_type(8)));
typedef short s16x4 __attribute__((ext_vector_type(4)));
typedef __bf16 bf16x2_t __attribute__((ext_vector_type(2)));

#ifndef MK_N_LAUNCHES
#define MK_N_LAUNCHES 1
#endif

constexpr int NWAVES = 8, NTHR = 512;
constexpr int D = 1024, TP = 16384, TS = 1024, T = TP + TS, SEQ = 4096, NB = 4, DB = 128, DL = 8;
constexpr int FF = 2816, ZP = 2816;
constexpr int ZK = 512, ZV = 640, ZHQ = 768, ZHF = 1280, ZHI = 1792, ZHG = 2304;
constexpr float EPS = 1e-6f;
constexpr int NPH = 13;

constexpr size_t MiB = 1u << 20;
constexpr size_t WS_WGU1 = 1 * MiB, WS_WD1 = 12 * MiB, WS_WIN = 17 * MiB + 512 * 1024, WS_WOUT = 23 * MiB, WS_WGU2 = 25 * MiB, WS_WD2 = 36 * MiB;
constexpr size_t WS_DEC = 42 * MiB, WS_XN = 43 * MiB, WS_HID = 77 * MiB, WS_Y = 171 * MiB, WS_END = 239 * MiB;
constexpr size_t OFF_KWP = (size_t)T * D, OFF_VWP = OFF_KWP + 65536, OFF_SP = OFF_VWP + 65536, OFF_KWS = OFF_SP + 262144, OFF_VWS = OFF_KWS + 2097152, OFF_SS = OFF_VWS + 2097152;
constexpr int LDS_BYTES = 147456;

#define MFMA32(a, b, c) __builtin_amdgcn_mfma_f32_32x32x16_bf16((a), (b), (c), 0, 0, 0)

__device__ __forceinline__ float bf2f(unsigned u) { return __uint_as_float(u << 16); }
__device__ __forceinline__ unsigned cvtpk(float lo, float hi) { f32x2 v = {lo, hi}; bf16x2_t b = __builtin_convertvector(v, bf16x2_t); return __builtin_bit_cast(unsigned, b); }
__device__ __forceinline__ float wave_sum(float v) {
#pragma unroll
    for (int o = 1; o < 64; o <<= 1) v += __shfl_xor(v, o);
    return v;
}
__device__ __forceinline__ float sigmoidf_(float x) { return __builtin_amdgcn_rcpf(1.f + __expf(-x)); }
__device__ __forceinline__ float siluf_(float x) { return x * sigmoidf_(x); }
__device__ __forceinline__ int crow(int reg, int h) { return (reg & 3) + 8 * (reg >> 2) + 4 * h; }

struct EpiSwiGLU {
    static constexpr bool PERM = true, AFTER_DRAIN = false;
    bf16* O; int ldo;
    __device__ __forceinline__ void operator()(const pg8::f32x4 (&acc)[2][2][4][2], const pg8::Unit& u, int wr, int wc, int fr, int fq) const {
        const int row0 = u.pm * 256 + wr * 64 + fr, j0 = u.pn * 128 + wc * 16 + 4 * fq;
#pragma unroll
        for (int ai = 0; ai < 2; ++ai)
#pragma unroll
            for (int m = 0; m < 4; ++m) { bf16* rowp = O + (size_t)(row0 + ai * 128 + m * 16) * ldo + j0;
#pragma unroll
                for (int bj = 0; bj < 2; ++bj) { const pg8::f32x4 v0 = acc[ai][bj][m][0], v1 = acc[ai][bj][m][1];
                    const float h0 = siluf_(v0[0]) * v0[1], h1 = siluf_(v0[2]) * v0[3], h2 = siluf_(v1[0]) * v1[1], h3 = siluf_(v1[2]) * v1[3];
                    v2u w; w.x = cvtpk(h0, h1); w.y = cvtpk(h2, h3);
                    *(v2u*)(rowp + bj * 64) = w; } }
    }
};
struct EpiF32 {
    static constexpr bool PERM = false, AFTER_DRAIN = false;
    float* O; int ldc;
    __device__ __forceinline__ void operator()(const pg8::f32x4 (&acc)[2][2][4][2], const pg8::Unit& u, int wr, int wc, int fr, int fq) const {
        const int row0 = u.pm * 256 + wr * 64 + fr, col0 = u.pn * 256 + wc * 32 + 4 * fq;
#pragma unroll
        for (int ai = 0; ai < 2; ++ai)
#pragma unroll
            for (int m = 0; m < 4; ++m) { float* rowp = O + (size_t)(row0 + ai * 128 + m * 16) * ldc + col0;
#pragma unroll
                for (int bj = 0; bj < 2; ++bj)
#pragma unroll
                    for (int n = 0; n < 2; ++n) *(pg8::f32x4*)(rowp + bj * 128 + n * 16) = acc[ai][bj][m][n]; }
    }
};

__device__ __forceinline__ void transpose_item(const float* W, int K, int N, bf16* WT, int split, int mul, LAS float* scr, int item, int lane) {
    const int nblk = N / 32, kb = item / nblk, nb = item % nblk, k0 = 64 * kb, n0 = 32 * nb;
#pragma unroll 8
    for (int i = 0; i < 32; ++i) { const int kk = 2 * i + (lane >> 5); scr[kk * 33 + (lane & 31)] = W[(size_t)(k0 + kk) * N + n0 + (lane & 31)]; }
    asm volatile("s_waitcnt lgkmcnt(0)" ::: "memory");
    const int c = lane & 7;
    const int part = n0 / split, nbase = (n0 - part * split);
#pragma unroll
    for (int j = 0; j < 4; ++j) { const int n = (lane >> 3) + 8 * j; const LAS float* s = scr + (8 * c) * 33 + n;
        v4u o; o.x = cvtpk(s[0 * 33], s[1 * 33]); o.y = cvtpk(s[2 * 33], s[3 * 33]); o.z = cvtpk(s[4 * 33], s[5 * 33]); o.w = cvtpk(s[6 * 33], s[7 * 33]);
        *(v4u*)(WT + (size_t)((nbase + n) * mul + part) * K + k0 + 8 * c) = o; }
    asm volatile("s_waitcnt lgkmcnt(0)" ::: "memory");
}
__device__ __forceinline__ void rms_row_bf16(const float* xrow, const float* g, bf16* orow, int lane) {
    f32x4 v[4]; float s = 0.f;
#pragma unroll
    for (int j = 0; j < 4; ++j) { v[j] = ((const f32x4*)xrow)[lane + 64 * j]; s += (v[j].x * v[j].x + v[j].y * v[j].y) + (v[j].z * v[j].z + v[j].w * v[j].w); }
    const float r = rsqrtf(wave_sum(s) * (1.f / D) + EPS);
#pragma unroll
    for (int j = 0; j < 4; ++j) { const f32x4 gg = ((const f32x4*)g)[lane + 64 * j]; const f32x4 o = v[j] * gg * r;
        v2u w; w.x = cvtpk(o.x, o.y); w.y = cvtpk(o.z, o.w); ((v2u*)orow)[lane + 64 * j] = w; }
}
__device__ __forceinline__ void row_update(const float* xin, const float* y, const float* gpost, float coef, float* xout, const float* gnext, bf16* xn, int lane) {
    f32x4 yv[4], xv[4]; float s = 0.f;
#pragma unroll
    for (int j = 0; j < 4; ++j) { yv[j] = ((const f32x4*)y)[lane + 64 * j]; s += (yv[j].x * yv[j].x + yv[j].y * yv[j].y) + (yv[j].z * yv[j].z + yv[j].w * yv[j].w); }
#pragma unroll
    for (int j = 0; j < 4; ++j) xv[j] = ((const f32x4*)xin)[lane + 64 * j];
    const float r = rsqrtf(wave_sum(s) * (1.f / D) + EPS) * coef;
    float s2 = 0.f;
#pragma unroll
    for (int j = 0; j < 4; ++j) { const f32x4 gg = ((const f32x4*)gpost)[lane + 64 * j]; xv[j] = xv[j] + yv[j] * gg * r;
        s2 += (xv[j].x * xv[j].x + xv[j].y * xv[j].y) + (xv[j].z * xv[j].z + xv[j].w * xv[j].w); ((f32x4*)xout)[lane + 64 * j] = xv[j]; }
    if (xn) {
        const float r2 = rsqrtf(wave_sum(s2) * (1.f / D) + EPS);
#pragma unroll
        for (int j = 0; j < 4; ++j) { const f32x4 gg = ((const f32x4*)gnext)[lane + 64 * j]; const f32x4 o = xv[j] * gg * r2;
            v2u w; w.x = cvtpk(o.x, o.y); w.y = cvtpk(o.z, o.w); ((v2u*)xn)[lane + 64 * j] = w; }
    }
}

constexpr int KSB = 144, VPB = 528;
__device__ __forceinline__ void attn_core(const LAS unsigned char* Ks, const LAS unsigned char* Vt, const bf16* qptr, bf16* optr, int kbase, int lo, int hi, float sink, int r, int h) {
    bf16x8 qf[4];
#pragma unroll
    for (int s = 0; s < 4; ++s) qf[s] = *(const bf16x8*)(qptr + 16 * s + 8 * h);
    f32x16 st[5];
#pragma unroll
    for (int kt = 0; kt < 5; ++kt) {
#pragma unroll
        for (int i = 0; i < 16; ++i) st[kt][i] = 0.f;
#pragma unroll
        for (int s = 0; s < 4; ++s) { const bf16x8 kf = *(const LAS bf16x8*)(Ks + (kbase + 32 * kt + r) * KSB + (16 * s + 8 * h) * 2); st[kt] = MFMA32(kf, qf[s], st[kt]); }
    }
    float mx = sink;
#pragma unroll
    for (int kt = 0; kt < 5; ++kt)
#pragma unroll
        for (int i = 0; i < 16; ++i) { const int j = kbase + 32 * kt + crow(i, h); const float v = (j >= lo && j <= hi) ? st[kt][i] * 0.125f : -INFINITY; st[kt][i] = v; mx = fmaxf(mx, v); }
    mx = fmaxf(mx, __shfl_xor(mx, 32));
    float sum = 0.f;
#pragma unroll
    for (int kt = 0; kt < 5; ++kt)
#pragma unroll
        for (int i = 0; i < 16; ++i) { const float p = __expf(st[kt][i] - mx); st[kt][i] = p; sum += p; }
    sum += __shfl_xor(sum, 32);
    const float inv = 1.f / (sum + __expf(sink - mx));
    f32x16 o[2];
#pragma unroll
    for (int mt = 0; mt < 2; ++mt)
#pragma unroll
        for (int i = 0; i < 16; ++i) o[mt][i] = 0.f;
#pragma unroll
    for (int kt = 0; kt < 5; ++kt)
#pragma unroll
        for (int s2 = 0; s2 < 2; ++s2) {
            v4u pw; pw.x = cvtpk(st[kt][8 * s2 + 0], st[kt][8 * s2 + 1]); pw.y = cvtpk(st[kt][8 * s2 + 2], st[kt][8 * s2 + 3]); pw.z = cvtpk(st[kt][8 * s2 + 4], st[kt][8 * s2 + 5]); pw.w = cvtpk(st[kt][8 * s2 + 6], st[kt][8 * s2 + 7]);
            const bf16x8 pb = __builtin_bit_cast(bf16x8, pw);
#pragma unroll
            for (int mt = 0; mt < 2; ++mt) {
                const LAS unsigned char* vp = Vt + (32 * mt + r) * VPB + (kbase + 32 * kt + 16 * s2 + 4 * h) * 2;
                const s16x4 l4 = *(const LAS s16x4*)vp, h4 = *(const LAS s16x4*)(vp + 16);
                const bf16x8 va = __builtin_shufflevector(l4, h4, 0, 1, 2, 3, 4, 5, 6, 7);
                o[mt] = MFMA32(va, pb, o[mt]);
            }
        }
#pragma unroll
    for (int mt = 0; mt < 2; ++mt)
#pragma unroll
        for (int i4 = 0; i4 < 4; ++i4) { v2u w; w.x = cvtpk(o[mt][4 * i4] * inv, o[mt][4 * i4 + 1] * inv); w.y = cvtpk(o[mt][4 * i4 + 2] * inv, o[mt][4 * i4 + 3] * inv);
            *(v2u*)(optr + 32 * mt + 8 * i4 + 4 * h) = w; }
}

struct Ctx {
    const float* in[22]; float* out; unsigned char* ws;
    bf16 *XN, *HID, *MIX; float *Y, *SLOC, *DEC;
    int tid, lane, wave;
};

__device__ __forceinline__ void attn_prompt_item(const Ctx& C, LAS unsigned char* lds, int item) {
    const int kvh = item & 1, n = (item >> 1) & 31, b = item >> 6;
    LAS unsigned char* Ks = lds; LAS unsigned char* Vt = lds + 256 * KSB;
    const bf16* Z = C.HID;
    {
        const int key = C.tid >> 1, dh = C.tid & 1, tok = (n - 1) * 128 + key;
        v4u kv[4], vv[4];
        if (tok >= 0) { const bf16* zr = Z + (size_t)(b * SEQ + tok) * ZP + kvh * 64 + dh * 32;
#pragma unroll
            for (int j = 0; j < 4; ++j) { kv[j] = *(const v4u*)(zr + ZK + 8 * j); vv[j] = *(const v4u*)(zr + ZV + 8 * j); }
        } else {
#pragma unroll
            for (int j = 0; j < 4; ++j) { kv[j] = (v4u){0u, 0u, 0u, 0u}; vv[j] = (v4u){0u, 0u, 0u, 0u}; }
        }
#pragma unroll
        for (int j = 0; j < 4; ++j) *(LAS v4u*)(Ks + key * KSB + dh * 64 + 16 * j) = kv[j];
#pragma unroll
        for (int j = 0; j < 4; ++j)
#pragma unroll
            for (int e = 0; e < 4; ++e) { const unsigned w = vv[j][e]; const int d = dh * 32 + 8 * j + 2 * e;
                *(LAS unsigned short*)(Vt + d * VPB + key * 2) = (unsigned short)(w & 0xffffu); *(LAS unsigned short*)(Vt + (d + 1) * VPB + key * 2) = (unsigned short)(w >> 16); }
        if (n == 31 && key >= 128) {
            float* ko = C.out + OFF_KWP + ((size_t)(b * 128 + key - 128) * 2 + kvh) * 64 + dh * 32; float* vo = C.out + OFF_VWP + ((size_t)(b * 128 + key - 128) * 2 + kvh) * 64 + dh * 32;
#pragma unroll
            for (int j = 0; j < 4; ++j) {
                *(f32x4*)(ko + 8 * j) = (f32x4){bf2f(kv[j][0] & 0xffffu), bf2f(kv[j][0] >> 16), bf2f(kv[j][1] & 0xffffu), bf2f(kv[j][1] >> 16)};
                *(f32x4*)(ko + 8 * j + 4) = (f32x4){bf2f(kv[j][2] & 0xffffu), bf2f(kv[j][2] >> 16), bf2f(kv[j][3] & 0xffffu), bf2f(kv[j][3] >> 16)};
                *(f32x4*)(vo + 8 * j) = (f32x4){bf2f(vv[j][0] & 0xffffu), bf2f(vv[j][0] >> 16), bf2f(vv[j][1] & 0xffffu), bf2f(vv[j][1] >> 16)};
                *(f32x4*)(vo + 8 * j + 4) = (f32x4){bf2f(vv[j][2] & 0xffffu), bf2f(vv[j][2] >> 16), bf2f(vv[j][3] & 0xffffu), bf2f(vv[j][3] >> 16)}; }
        }
    }
    __syncthreads();
    const int g = C.wave >> 1, qh = C.wave & 1, r = C.lane & 31, h = C.lane >> 5;
    const float sink = C.in[7][kvh * 4 + g];
#pragma unroll 1
    for (int sb = 0; sb < 2; ++sb) {
        const int q0 = 64 * qh + 32 * sb, qi = q0 + r; const size_t row = (size_t)(b * SEQ + n * 128 + qi);
        attn_core(Ks, Vt, Z + row * ZP + kvh * 256 + g * 64, C.MIX + row * D + kvh * 256 + g * 64, q0, (n == 0) ? 128 : qi, qi + 128, sink, r, h);
    }
    __syncthreads();
}
__device__ __forceinline__ void attn_sample_item(const Ctx& C, LAS unsigned char* lds, int item) {
    const int kvh = item & 1, b = item >> 1;
    LAS unsigned char* Ks = lds; LAS unsigned char* Vt = lds + 256 * KSB;
    const bf16* Z = C.HID; const float* ck = C.in[2]; const float* cv = C.in[3];
    for (int idx = C.tid; idx < 160 * 16; idx += NTHR) {
        const int j = idx >> 4, d4 = (idx & 15) * 4;
        f32x4 kf = {0.f, 0.f, 0.f, 0.f}, vf = {0.f, 0.f, 0.f, 0.f};
        if (j < 128) { const size_t o = ((size_t)(b * 128 + j) * 2 + kvh) * 64 + d4; kf = *(const f32x4*)(ck + o); vf = *(const f32x4*)(cv + o); }
        else if (j < 136) { const bf16* zr = Z + (size_t)(TP + b * DL + j - 128) * ZP + kvh * 64 + d4; const v2u kw = *(const v2u*)(zr + ZK), vw = *(const v2u*)(zr + ZV);
            kf = (f32x4){bf2f(kw.x & 0xffffu), bf2f(kw.x >> 16), bf2f(kw.y & 0xffffu), bf2f(kw.y >> 16)}; vf = (f32x4){bf2f(vw.x & 0xffffu), bf2f(vw.x >> 16), bf2f(vw.y & 0xffffu), bf2f(vw.y >> 16)}; }
        if (j >= 8 && j < 136) { const size_t o = ((size_t)(b * 128 + j - 8) * 2 + kvh) * 64 + d4; *(f32x4*)(C.out + OFF_KWS + o) = kf; *(f32x4*)(C.out + OFF_VWS + o) = vf; }
        v2u kw; kw.x = cvtpk(kf.x, kf.y); kw.y = cvtpk(kf.z, kf.w); *(LAS v2u*)(Ks + j * KSB + d4 * 2) = kw;
        const unsigned v01 = cvtpk(vf.x, vf.y), v23 = cvtpk(vf.z, vf.w);
        *(LAS unsigned short*)(Vt + (d4 + 0) * VPB + j * 2) = (unsigned short)(v01 & 0xffffu); *(LAS unsigned short*)(Vt + (d4 + 1) * VPB + j * 2) = (unsigned short)(v01 >> 16);
        *(LAS unsigned short*)(Vt + (d4 + 2) * VPB + j * 2) = (unsigned short)(v23 & 0xffffu); *(LAS unsigned short*)(Vt + (d4 + 3) * VPB + j * 2) = (unsigned short)(v23 >> 16);
    }
    __syncthreads();
    if (C.wave == 0) {
        const int r = C.lane & 31, h = C.lane >> 5, g = r >> 3, i = r & 7; const size_t row = (size_t)(TP + b * DL + i);
        attn_core(Ks, Vt, Z + row * ZP + kvh * 256 + g * 64, C.MIX + row * D + kvh * 256 + g * 64, 0, i, 128 + i, C.in[7][kvh * 4 + g], r, h);
    }
    __syncthreads();
}

constexpr int TPB = 144;
constexpr int KQB = 272;
__device__ __forceinline__ void hgrn_local_item(const Ctx& C, LAS unsigned char* lds, int item) {
    const int c = item & 63, h = (item >> 6) & 3, b = item >> 8;
    const bf16* Z = C.HID + (size_t)(b * SEQ + c * 64) * ZP;
    LAS unsigned char* KtT = lds; LAS unsigned char* VT = lds + 128 * TPB; LAS float* segs = (LAS float*)(lds + 2 * 128 * TPB);
    const int seg = C.tid >> 7, k = C.tid & 127;
    const float l0 = C.in[9][h * 128 + k], l1 = C.in[9][512 + h * 128 + k], lb = sigmoidf_(l0 - l1);
    float G[16], kk[16]; float cum = 0.f; unsigned vraw[16];
#pragma unroll
    for (int e = 0; e < 16; ++e) { const bf16* zr = Z + (size_t)(seg * 16 + e) * ZP + h * 128 + k; const float hf = bf2f(zr[ZHF]); vraw[e] = zr[ZHI];
        const float sg = sigmoidf_(hf), f = lb + (1.f - lb) * sg; cum += __logf(f); G[e] = cum; kk[e] = 1.f - f; }
    segs[seg * 128 + k] = cum;
    __syncthreads();
    float off = 0.f, tot = 0.f;
#pragma unroll
    for (int s = 0; s < 4; ++s) { const float v = segs[s * 128 + k]; tot += v; if (s < seg) off += v; }
    {
        unsigned kw[8], vw[8];
#pragma unroll
        for (int e = 0; e < 8; ++e) { kw[e] = cvtpk(kk[2 * e] * __expf(tot - off - G[2 * e]), kk[2 * e + 1] * __expf(tot - off - G[2 * e + 1])); vw[e] = vraw[2 * e] | (vraw[2 * e + 1] << 16); }
        *(LAS v4u*)(KtT + k * TPB + seg * 32) = (v4u){kw[0], kw[1], kw[2], kw[3]}; *(LAS v4u*)(KtT + k * TPB + seg * 32 + 16) = (v4u){kw[4], kw[5], kw[6], kw[7]};
        *(LAS v4u*)(VT + k * TPB + seg * 32) = (v4u){vw[0], vw[1], vw[2], vw[3]}; *(LAS v4u*)(VT + k * TPB + seg * 32 + 16) = (v4u){vw[4], vw[5], vw[6], vw[7]};
    }
    if (seg == 0) C.DEC[(size_t)item * 128 + k] = __expf(tot);
    __syncthreads();
    const int r = C.lane & 31, h2 = C.lane >> 5, vt = C.wave >> 1;
    float* So = C.SLOC + (size_t)item * 16384;
#pragma unroll
    for (int kk2 = 0; kk2 < 2; ++kk2) {
        const int kt = (C.wave & 1) * 2 + kk2;
        f32x16 acc;
#pragma unroll
        for (int i = 0; i < 16; ++i) acc[i] = 0.f;
#pragma unroll
        for (int s = 0; s < 4; ++s) { const bf16x8 a = *(const LAS bf16x8*)(VT + (32 * vt + r) * TPB + (16 * s + 8 * h2) * 2), bb = *(const LAS bf16x8*)(KtT + (32 * kt + r) * TPB + (16 * s + 8 * h2) * 2);
            acc = MFMA32(a, bb, acc); }
#pragma unroll
        for (int i = 0; i < 16; ++i) So[(32 * vt + crow(i, h2)) * 128 + 32 * kt + r] = acc[i];
    }
    __syncthreads();
}
__device__ __forceinline__ void hgrn_out_item(const Ctx& C, LAS unsigned char* lds, int item) {
    const int c = item & 63, h = (item >> 6) & 3, b = item >> 8;
    const size_t row0 = (size_t)(b * SEQ + c * 64);
    const bf16* Z = C.HID + row0 * ZP;
    LAS unsigned char* Qt = lds; LAS unsigned char* Kt2 = lds + 64 * KQB; LAS unsigned char* VT = lds + 2 * 64 * KQB; LAS unsigned char* ST = VT + 128 * TPB;
    LAS float* segs = (LAS float*)(ST + 128 * KQB); LAS float* part = segs + 512;
    const int seg = C.tid >> 7, k = C.tid & 127;
    const float l0 = C.in[9][h * 128 + k], l1 = C.in[9][512 + h * 128 + k], lb = sigmoidf_(l0 - l1);
    float G[16], kk[16], qq[16]; float cum = 0.f; unsigned vraw[16];
#pragma unroll
    for (int e = 0; e < 16; ++e) { const bf16* zr = Z + (size_t)(seg * 16 + e) * ZP + h * 128 + k; const float hf = bf2f(zr[ZHF]); vraw[e] = zr[ZHI]; qq[e] = siluf_(bf2f(zr[ZHQ]));
        const float sg = sigmoidf_(hf), f = lb + (1.f - lb) * sg; cum += __logf(f); G[e] = cum; kk[e] = 1.f - f; }
    segs[seg * 128 + k] = cum;
    {
        const float* Ss = C.SLOC + (size_t)item * 16384;
#pragma unroll
        for (int j = 0; j < 8; ++j) { const int e = (j * NTHR + C.tid) * 4, v = e >> 7, k4 = e & 127; const f32x4 s4 = *(const f32x4*)(Ss + e);
            v2u w; w.x = cvtpk(s4.x, s4.y); w.y = cvtpk(s4.z, s4.w); *(LAS v2u*)(ST + v * KQB + k4 * 2) = w; }
    }
    __syncthreads();
    float off = 0.f;
#pragma unroll
    for (int s = 0; s < 4; ++s) { const float v = segs[s * 128 + k]; if (s < seg) off += v; }
    {
        unsigned vw[8];
#pragma unroll
        for (int e = 0; e < 16; ++e) { const float g = off + G[e]; const int t = seg * 16 + e;
            *(LAS unsigned short*)(Qt + t * KQB + k * 2) = (unsigned short)(cvtpk(qq[e] * __expf(g), 0.f) & 0xffffu);
            *(LAS unsigned short*)(Kt2 + t * KQB + k * 2) = (unsigned short)(cvtpk(kk[e] * __expf(-g), 0.f) & 0xffffu); }
#pragma unroll
        for (int e = 0; e < 8; ++e) vw[e] = vraw[2 * e] | (vraw[2 * e + 1] << 16);
        *(LAS v4u*)(VT + k * TPB + seg * 32) = (v4u){vw[0], vw[1], vw[2], vw[3]}; *(LAS v4u*)(VT + k * TPB + seg * 32 + 16) = (v4u){vw[4], vw[5], vw[6], vw[7]};
    }
    __syncthreads();
    const int r = C.lane & 31, h2 = C.lane >> 5, vt = C.wave >> 1, tt = C.wave & 1;
    bf16x8 qf[8];
#pragma unroll
    for (int ks = 0; ks < 8; ++ks) qf[ks] = *(const LAS bf16x8*)(Qt + (32 * tt + r) * KQB + (16 * ks + 8 * h2) * 2);
    f32x16 acc;
#pragma unroll
    for (int i = 0; i < 16; ++i) acc[i] = 0.f;
#pragma unroll
    for (int ks = 0; ks < 8; ++ks) { const bf16x8 a = *(const LAS bf16x8*)(ST + (32 * vt + r) * KQB + (16 * ks + 8 * h2) * 2); acc = MFMA32(a, qf[ks], acc); }
#pragma unroll
    for (int st = 0; st < 2; ++st) {
        if (st <= tt) {
            f32x16 X;
#pragma unroll
            for (int i = 0; i < 16; ++i) X[i] = 0.f;
#pragma unroll
            for (int ks = 0; ks < 8; ++ks) { const bf16x8 a = *(const LAS bf16x8*)(Kt2 + (32 * st + r) * KQB + (16 * ks + 8 * h2) * 2); X = MFMA32(a, qf[ks], X); }
#pragma unroll
            for (int i = 0; i < 16; ++i) { const int s = 32 * st + crow(i, h2), t = 32 * tt + r; X[i] = (s <= t) ? X[i] : 0.f; }
#pragma unroll
            for (int s2 = 0; s2 < 2; ++s2) {
                v4u pw; pw.x = cvtpk(X[8 * s2 + 0], X[8 * s2 + 1]); pw.y = cvtpk(X[8 * s2 + 2], X[8 * s2 + 3]); pw.z = cvtpk(X[8 * s2 + 4], X[8 * s2 + 5]); pw.w = cvtpk(X[8 * s2 + 6], X[8 * s2 + 7]);
                const bf16x8 pb = __builtin_bit_cast(bf16x8, pw);
                const LAS unsigned char* vp = VT + (32 * vt + r) * TPB + (32 * st + 16 * s2 + 4 * h2) * 2;
                const s16x4 l4 = *(const LAS s16x4*)vp, h4 = *(const LAS s16x4*)(vp + 16);
                acc = MFMA32(__builtin_shufflevector(l4, h4, 0, 1, 2, 3, 4, 5, 6, 7), pb, acc);
            }
        }
    }
    float ssq = 0.f;
#pragma unroll
    for (int i = 0; i < 16; ++i) ssq += acc[i] * acc[i];
    ssq += __shfl_xor(ssq, 32);
    if (h2 == 0) part[vt * 64 + 32 * tt + r] = ssq;
    __syncthreads();
    const int t = 32 * tt + r;
    const float tot = (part[t] + part[64 + t]) + (part[128 + t] + part[192 + t]);
    const float rinv = rsqrtf(tot * (1.f / 128.f) + EPS);
    const bf16* zg = Z + (size_t)t * ZP + ZHG + h * 128 + 32 * vt + 4 * h2;
    bf16* mo = C.MIX + (row0 + t) * D + 512 + h * 128 + 32 * vt + 4 * h2;
    const float* gn = C.in[10] + 32 * vt + 4 * h2;
#pragma unroll
    for (int i4 = 0; i4 < 4; ++i4) { const v2u gw = *(const v2u*)(zg + 8 * i4); const f32x4 gg = *(const f32x4*)(gn + 8 * i4);
        const float o0 = acc[4 * i4] * rinv * gg.x * siluf_(bf2f(gw.x & 0xffffu)), o1 = acc[4 * i4 + 1] * rinv * gg.y * siluf_(bf2f(gw.x >> 16));
        const float o2 = acc[4 * i4 + 2] * rinv * gg.z * siluf_(bf2f(gw.y & 0xffffu)), o3 = acc[4 * i4 + 3] * rinv * gg.w * siluf_(bf2f(gw.y >> 16));
        v2u w; w.x = cvtpk(o0, o1); w.y = cvtpk(o2, o3); *(v2u*)(mo + 8 * i4) = w; }
    __syncthreads();
}
__device__ __forceinline__ void hgrn_sample_item(const Ctx& C, LAS unsigned char* lds, int item) {
    const int h = item & 3, b = item >> 2;
    LAS float* fA = (LAS float*)lds; LAS float* kA = fA + 1024; LAS float* qA = kA + 1024; LAS float* vA = qA + 1024; LAS float* gA = vA + 1024; LAS float* part = gA + 1024;
    {
        const int t = C.tid >> 6, c2 = (C.tid & 63) * 2; const bf16* zr = C.HID + (size_t)(TP + b * DL + t) * ZP + h * 128 + c2;
        const unsigned wq = *(const unsigned*)(zr + ZHQ), wf = *(const unsigned*)(zr + ZHF), wi = *(const unsigned*)(zr + ZHI), wg = *(const unsigned*)(zr + ZHG);
#pragma unroll
        for (int e = 0; e < 2; ++e) { const int k = c2 + e; const float l0 = C.in[9][h * 128 + k], l1 = C.in[9][512 + h * 128 + k], lb = sigmoidf_(l0 - l1);
            const float hq = bf2f(e ? (wq >> 16) : (wq & 0xffffu)), hf = bf2f(e ? (wf >> 16) : (wf & 0xffffu)), hi = bf2f(e ? (wi >> 16) : (wi & 0xffffu)), hg = bf2f(e ? (wg >> 16) : (wg & 0xffffu));
            const float f = lb + (1.f - lb) * sigmoidf_(hf);
            fA[t * 128 + k] = f; kA[t * 128 + k] = 1.f - f; qA[t * 128 + k] = siluf_(hq); vA[t * 128 + k] = hi; gA[t * 128 + k] = siluf_(hg); }
    }
    __syncthreads();
    const int v4 = C.tid & 31, kg = C.tid >> 5;
    const float* S0 = C.in[4] + ((size_t)(b * 4 + h) * 128 + kg * 8) * 128 + v4 * 4;
    f32x4 S[8];
#pragma unroll
    for (int i = 0; i < 8; ++i) S[i] = *(const f32x4*)(S0 + i * 128);
#pragma unroll
    for (int t = 0; t < 8; ++t) {
        const f32x4 vv = *(const LAS f32x4*)(vA + t * 128 + v4 * 4); f32x4 po = {0.f, 0.f, 0.f, 0.f};
#pragma unroll
        for (int i = 0; i < 8; ++i) { const int k = kg * 8 + i; const float f = fA[t * 128 + k], kk = kA[t * 128 + k], q = qA[t * 128 + k]; S[i] = S[i] * f + vv * kk; po += S[i] * q; }
        *(LAS f32x4*)(part + (t * 16 + kg) * 128 + v4 * 4) = po;
    }
    float* So = C.out + OFF_SS + ((size_t)(b * 4 + h) * 128 + kg * 8) * 128 + v4 * 4;
#pragma unroll
    for (int i = 0; i < 8; ++i) *(f32x4*)(So + i * 128) = S[i];
    __syncthreads();
    {
        const int t = C.tid >> 6, c2 = (C.tid & 63) * 2; float o0 = 0.f, o1 = 0.f;
#pragma unroll
        for (int j = 0; j < 16; ++j) { const f32x2 p = *(const LAS f32x2*)(part + (t * 16 + j) * 128 + c2); o0 += p.x; o1 += p.y; }
        const float rinv = rsqrtf(wave_sum(o0 * o0 + o1 * o1) * (1.f / 128.f) + EPS);
        const float g0 = C.in[10][c2], g1 = C.in[10][c2 + 1];
        *(unsigned*)(C.MIX + (size_t)(TP + b * DL + t) * D + 512 + h * 128 + c2) = cvtpk(o0 * rinv * g0 * gA[t * 128 + c2], o1 * rinv * g1 * gA[t * 128 + c2 + 1]);
    }
    __syncthreads();
}

struct Args { const float* in[22]; float* out; unsigned char* ws; int ph_lo, ph_hi; };

__global__ void __launch_bounds__(NTHR, 2) fwd(Args args) {
    extern __shared__ __attribute__((aligned(16))) unsigned char lds_raw[];
    LAS unsigned char* lds = (LAS unsigned char*)lds_raw;
    Ctx C;
#pragma unroll
    for (int i = 0; i < 22; ++i) C.in[i] = args.in[i];
    C.out = args.out; C.ws = args.ws;
    C.XN = (bf16*)(args.ws + WS_XN); C.HID = (bf16*)(args.ws + WS_HID); C.MIX = C.XN; C.Y = (float*)(args.ws + WS_Y); C.SLOC = C.Y; C.DEC = (float*)(args.ws + WS_DEC);
    C.tid = threadIdx.x; C.lane = C.tid & 63; C.wave = __builtin_amdgcn_readfirstlane(C.tid >> 6);
    bf16* Wgu1 = (bf16*)(args.ws + WS_WGU1); bf16* Wd1 = (bf16*)(args.ws + WS_WD1); bf16* Win = (bf16*)(args.ws + WS_WIN); bf16* Wout = (bf16*)(args.ws + WS_WOUT);
    bf16* Wgu2 = (bf16*)(args.ws + WS_WGU2); bf16* Wd2 = (bf16*)(args.ws + WS_WD2);
    const int G = gridDim.x, bid = blockIdx.x, gw = bid * NWAVES + C.wave, NGW = G * NWAVES;
    const int lo = args.ph_lo, hi = args.ph_hi;
    cg::grid_group grid = cg::this_grid();
#define IN(k) (lo <= (k) && (k) < hi)
#define SEAM(k) do { if (IN(k) && IN((k) + 1)) grid.sync(); } while (0)
#define XROW(m) ((m) < TP ? C.in[0] + (size_t)(m) * D : C.in[1] + (size_t)((m) - TP) * D)

    if (IN(0)) {
        LAS float* scr = (LAS float*)(lds + C.wave * 16384);
        constexpr int I_GU = 16 * 176, I_DN = 44 * 32, I_IN = 16 * 88, I_OUT = 16 * 32, NIT = 2 * I_GU + 2 * I_DN + I_IN + I_OUT;
        for (int it = gw; it < NIT; it += NGW) {
            int r = it;
            if (r < I_GU) { transpose_item(C.in[12], D, 2 * FF, Wgu1, FF, 2, scr, r, C.lane); continue; } r -= I_GU;
            if (r < I_GU) { transpose_item(C.in[14], D, 2 * FF, Wgu2, FF, 2, scr, r, C.lane); continue; } r -= I_GU;
            if (r < I_DN) { transpose_item(C.in[13], FF, D, Wd1, D, 1, scr, r, C.lane); continue; } r -= I_DN;
            if (r < I_DN) { transpose_item(C.in[15], FF, D, Wd2, D, 1, scr, r, C.lane); continue; } r -= I_DN;
            if (r < I_IN) { transpose_item(C.in[5], D, ZP, Win, ZP, 1, scr, r, C.lane); continue; } r -= I_IN;
            transpose_item(C.in[11], D, D, Wout, D, 1, scr, r, C.lane);
        }
        for (int m = gw; m < T; m += NGW) rms_row_bf16(XROW(m), C.in[16], C.XN + (size_t)m * D, C.lane);
    }
    SEAM(0);
    if (IN(1)) { pg8::Gemm g{C.XN, Wgu1, T, 2 * FF, D}; pg8::StaticOrder S; S.init(T, 2 * FF, G, bid); EpiSwiGLU E{C.HID, FF};
        pg8::gemm_phase<EpiSwiGLU, pg8::StaticOrder, true, true>(lds, g, S, E); }
    SEAM(1);
    if (IN(2)) { pg8::Gemm g{C.HID, Wd1, T, D, FF}; pg8::StaticOrder S; S.init(T, D, G, bid); EpiF32 E{C.Y, D};
        pg8::gemm_phase<EpiF32, pg8::StaticOrder, true, true>(lds, g, S, E); }
    SEAM(2);
    if (IN(3)) { for (int m = gw; m < T; m += NGW) row_update(XROW(m), C.Y + (size_t)m * D, C.in[17], 0.5f, C.out + (size_t)m * D, C.in[18], C.XN + (size_t)m * D, C.lane); }
    SEAM(3);
    if (IN(4)) { pg8::Gemm g{C.XN, Win, T, ZP, D}; pg8::StaticOrder S; S.init(T, ZP, G, bid); pg8::EpiBf16<0> E{C.HID, ZP, C.in[6], 0, 0, 1.f};
        pg8::gemm_phase<pg8::EpiBf16<0>, pg8::StaticOrder, true, true>(lds, g, S, E); }
    SEAM(4);
    if (IN(5)) {
        for (int it = bid; it < 2048; it += G) {
            if (it < 1024) hgrn_local_item(C, lds, it);
            else if (it < 1280) attn_prompt_item(C, lds, it - 1024);
            else if (it < 1792) hgrn_sample_item(C, lds, it - 1280);
            else attn_sample_item(C, lds, it - 1792);
        }
    }
    SEAM(5);
    if (IN(6)) {
        for (int idx = bid * NTHR + C.tid; idx < 16 * 8192; idx += G * NTHR) {
            const int bh = idx >> 13, e2 = idx & 8191, v = e2 >> 6, k2 = (e2 & 63) * 2;
            f32x2 S = {0.f, 0.f};
            float* p = C.SLOC + (size_t)bh * 64 * 16384 + v * 128 + k2; const float* dp = C.DEC + (size_t)bh * 64 * 128 + k2;
#pragma unroll 8
            for (int c = 0; c < 64; ++c) { const f32x2 tmp = *(const f32x2*)(p + (size_t)c * 16384); const f32x2 d = *(const f32x2*)(dp + c * 128); *(f32x2*)(p + (size_t)c * 16384) = S; S = d * S + tmp; }
            float* so = C.out + OFF_SP + (size_t)bh * 16384 + (size_t)k2 * 128 + v; so[0] = S.x; so[128] = S.y;
        }
        for (int m = gw; m < T; m += NGW) {
            bf16* ar = C.MIX + (size_t)m * D + C.lane * 8; const v4u w = *(const v4u*)ar; float x[8]; float s = 0.f;
#pragma unroll
            for (int j = 0; j < 4; ++j) { x[2 * j] = bf2f(w[j] & 0xffffu); x[2 * j + 1] = bf2f(w[j] >> 16); s += x[2 * j] * x[2 * j] + x[2 * j + 1] * x[2 * j + 1]; }
            const float r = rsqrtf(wave_sum(s) * (1.f / 512.f) + EPS); const float* gp = C.in[8] + C.lane * 8; const f32x4 g0 = *(const f32x4*)gp, g1 = *(const f32x4*)(gp + 4);
            v4u o; o.x = cvtpk(x[0] * r * g0.x, x[1] * r * g0.y); o.y = cvtpk(x[2] * r * g0.z, x[3] * r * g0.w); o.z = cvtpk(x[4] * r * g1.x, x[5] * r * g1.y); o.w = cvtpk(x[6] * r * g1.z, x[7] * r * g1.w);
            *(v4u*)ar = o;
        }
    }
    SEAM(6);
    if (IN(7)) { for (int it = bid; it < 1024; it += G) hgrn_out_item(C, lds, it); }
    SEAM(7);
    if (IN(8)) { pg8::Gemm g{C.MIX, Wout, T, D, D}; pg8::StaticOrder S; S.init(T, D, G, bid); EpiF32 E{C.Y, D};
        pg8::gemm_phase<EpiF32, pg8::StaticOrder, true, true>(lds, g, S, E); }
    SEAM(8);
    if (IN(9)) { for (int m = gw; m < T; m += NGW) row_update(C.out + (size_t)m * D, C.Y + (size_t)m * D, C.in[19], 1.0f, C.out + (size_t)m * D, C.in[20], C.XN + (size_t)m * D, C.lane); }
    SEAM(9);
    if (IN(10)) { pg8::Gemm g{C.XN, Wgu2, T, 2 * FF, D}; pg8::StaticOrder S; S.init(T, 2 * FF, G, bid); EpiSwiGLU E{C.HID, FF};
        pg8::gemm_phase<EpiSwiGLU, pg8::StaticOrder, true, true>(lds, g, S, E); }
    SEAM(10);
    if (IN(11)) { pg8::Gemm g{C.HID, Wd2, T, D, FF}; pg8::StaticOrder S; S.init(T, D, G, bid); EpiF32 E{C.Y, D};
        pg8::gemm_phase<EpiF32, pg8::StaticOrder, true, true>(lds, g, S, E); }
    SEAM(11);
    if (IN(12)) { for (int m = gw; m < T; m += NGW) row_update(C.out + (size_t)m * D, C.Y + (size_t)m * D, C.in[21], 0.5f, C.out + (size_t)m * D, nullptr, nullptr, C.lane); }
#undef IN
#undef SEAM
#undef XROW
}

extern "C" void kernel_launch(void* const* d_in, const int* in_sizes, int n_in, void* d_out, int out_size, void* d_ws, size_t ws_size, hipStream_t stream) {
    static int grid = 0;
    if (grid == 0) {
        if (n_in != 22 || ws_size < WS_END) { fprintf(stderr, "kernel_launch: unexpected inputs (n_in %d, ws %zu)\n", n_in, ws_size); grid = -1; return; }
        int dev = 0, cus = 0, per_cu = 0;
        hipGetDevice(&dev); hipDeviceGetAttribute(&cus, hipDeviceAttributeMultiprocessorCount, dev);
        if (hipFuncSetAttribute((const void*)fwd, hipFuncAttributeMaxDynamicSharedMemorySize, LDS_BYTES) != hipSuccess) { fprintf(stderr, "kernel_launch: hipFuncSetAttribute failed\n"); grid = -1; return; }
        if (hipOccupancyMaxActiveBlocksPerMultiprocessor(&per_cu, (const void*)fwd, NTHR, LDS_BYTES) != hipSuccess || per_cu < 1) per_cu = 1;
        (void)hipGetLastError();
        grid = cus * per_cu;
    }
    if (grid < 0) return;
    Args a{};
    for (int i = 0; i < 22; ++i) a.in[i] = (const float*)d_in[i];
    a.out = (float*)d_out; a.ws = (unsigned char*)d_ws;
#if MK_N_LAUNCHES == 1
    a.ph_lo = 0; a.ph_hi = NPH;
    void* kargs[] = {&a};
    hipError_t e = hipLaunchCooperativeKernel((const void*)fwd, dim3(grid), dim3(NTHR), kargs, LDS_BYTES, stream);
    if (e != hipSuccess) fprintf(stderr, "cooperative launch failed: %s (grid %d)\n", hipGetErrorString(e), grid);
#else
    for (int p = 0; p < NPH; ++p) { a.ph_lo = p; a.ph_hi = p + 1; hipLaunchKernelGGL(fwd, dim3(grid), dim3(NTHR), LDS_BYTES, stream, a); }
#endif
}
```

```cpp
#include <hip/hip_runtime.h>
#include <cstdio>
#include <cstdint>
namespace pg8 {
#define PG8_LAS __attribute__((address_space(3)))
typedef unsigned short bf16_t;
typedef short bf16x8 __attribute__((ext_vector_type(8)));
typedef float f32x4 __attribute__((ext_vector_type(4)));
typedef unsigned u32x4 __attribute__((ext_vector_type(4)));
constexpr int BM = 256, BK = 64, HALF = 128, HTB = HALF * BK * 2  , STAGE_BYTES = 8 * HTB, NXCD = 8, WGM = 8;

__host__ __device__ __forceinline__ int lds_byte(int r, int c) { const int st = (r >> 4) * 2 + (c >> 5), rr = r & 15, cc = c & 31, ob = rr * 64 + cc * 2; return st * 1024 + (ob ^ (((ob >> 9) & 1) << 5)); }
__host__ __device__ __forceinline__ void stage_rc(int b, int& R, int& C) { const int st = b / 1024, sb = b % 1024, swz = sb ^ (((sb >> 9) & 1) << 5); R = (st >> 1) * 16 + swz / 64; C = (st & 1) * 32 + (swz % 64) / 2; }
__host__ __device__ __forceinline__ int perm32(int rho) { const int n = rho >> 4, i = rho & 15; return 8 * (i >> 2) + 4 * n + (i & 3); }

struct Unit { int pm, pn, k0, nk, part; };
struct Gemm { const bf16_t* A; const bf16_t* Bt; int M, N, K; };

struct StaticOrder {
    int nM, nN, nwg, G, c, nkf;
    __host__ __device__ void init(int M, int N, int G_, int c_, int K) { nM = M / BM; nN = N / BM; nwg = nM * nN; G = G_; c = c_; nkf = K / BK; }
    __host__ __device__ bool next(int i, Unit& u) const {
        const long L = (long)i * G + c; if (L >= nwg) return false;
        int wgid = (int)L; { const int q = nwg / NXCD, r = nwg % NXCD, xcd = wgid % NXCD, off = wgid / NXCD; wgid = (xcd < r ? xcd * (q + 1) : r * (q + 1) + (xcd - r) * q) + off; }
        const int nig = WGM * nN, gid = wgid / nig, fm = gid * WGM, gsz = (nM - fm) < WGM ? (nM - fm) : WGM;
        u.pm = fm + ((wgid % nig) % gsz); u.pn = (wgid % nig) / gsz; u.k0 = 0; u.nk = nkf; u.part = -1; return true;
    }
    __device__ __forceinline__ void a_ready(const Unit&) const {}
    __device__ __forceinline__ void done(const Unit&) const {}
};

__device__ __forceinline__ unsigned cvt_pk_bf16(float lo, float hi) { unsigned r; asm volatile("v_cvt_pk_bf16_f32 %0, %1, %2" : "=v"(r) : "v"(lo), "v"(hi)); return r; }
typedef float f32x2 __attribute__((ext_vector_type(2)));
__device__ __forceinline__ f32x2 gelu_pk(f32x2 v) {
    const f32x2 av = __builtin_elementwise_abs(v), d = av * 0.2316418882f + 1.0f;
    f32x2 t; t.x = __builtin_amdgcn_rcpf(d.x); t.y = __builtin_amdgcn_rcpf(d.y);
    f32x2 q = t * 0.5307027145f + (-0.7265760135f); q = q * t + 0.7107068705f; q = q * t + (-0.142248368f); q = q * t + 0.127414796f; q = q * t;
    const f32x2 s = (v * v) * (-0.72134752044f);
    f32x2 e; e.x = __builtin_amdgcn_exp2f(s.x); e.y = __builtin_amdgcn_exp2f(s.y);
    const f32x2 m = v * (q * e), r = v - m;
    f32x2 o; o.x = v.x < 0.f ? m.x : r.x; o.y = v.y < 0.f ? m.y : r.y; return o;
}

template <int ACT  > struct EpiBf16 {
    static constexpr bool PERM = true, AFTER_DRAIN = false; static_assert(ACT == 0 || ACT == 1, "EpiBf16: ACT is 0 (none) or 1 (gelu_pk)");
    bf16_t* O; int ldc; const float* bias; int split_cols; size_t split_stride; float scale0;
    __device__ __forceinline__ void operator()(const f32x4 (&acc)[2][2][4][2], const Unit& u, int wr, int wc, int fr, int fq) const {
        const int row0 = u.pm * BM + wr * 64 + fr; int colt = u.pn * BM; bf16_t* base = O;
        float sc = 1.f; if (split_cols) { const int t = colt / split_cols; base += (size_t)t * split_stride; colt -= t * split_cols; if (t == 0) sc = scale0; }
        const int col0 = colt + wc * 32 + 8 * fq, bcol0 = u.pn * BM + wc * 32 + 8 * fq;
        f32x4 bv[2][2];
#pragma unroll
        for (int bj = 0; bj < 2; ++bj)
#pragma unroll
            for (int n = 0; n < 2; ++n) bv[bj][n] = bias ? *(const f32x4*)(bias + bcol0 + bj * HALF + 4 * n) : (f32x4){0.f, 0.f, 0.f, 0.f};
#pragma unroll
        for (int ai = 0; ai < 2; ++ai)
#pragma unroll
            for (int m = 0; m < 4; ++m) { bf16_t* rowp = base + (size_t)(row0 + ai * HALF + m * 16) * ldc + col0;
#pragma unroll
                for (int bj = 0; bj < 2; ++bj) { f32x4 v0 = acc[ai][bj][m][0] + bv[bj][0], v1 = acc[ai][bj][m][1] + bv[bj][1];
                    if (ACT == 1) { f32x2 a = gelu_pk((f32x2){v0[0], v0[1]}), b = gelu_pk((f32x2){v0[2], v0[3]}), c = gelu_pk((f32x2){v1[0], v1[1]}), d = gelu_pk((f32x2){v1[2], v1[3]});
                        v0 = (f32x4){a.x, a.y, b.x, b.y}; v1 = (f32x4){c.x, c.y, d.x, d.y}; }
                    v0 = v0 * sc; v1 = v1 * sc; u32x4 w; w.x = cvt_pk_bf16(v0[0], v0[1]); w.y = cvt_pk_bf16(v0[2], v0[3]); w.z = cvt_pk_bf16(v1[0], v1[1]); w.w = cvt_pk_bf16(v1[2], v1[3]);
                    *(u32x4*)(rowp + bj * HALF) = w; } }
    }
};
template <class Epi, class Sched, bool ALIGN_EPI = false, bool SP2 = false>
__device__ __forceinline__ void gemm_phase(PG8_LAS unsigned char* lds, const Gemm g, const Sched& S, const Epi& E) {
    const int tid = threadIdx.x, wid = __builtin_amdgcn_readfirstlane(tid >> 6), lane = tid & 63, wr = wid >> 2, wc = wid & 3, fr = lane & 15, fq = lane >> 4;
    const int K = g.K;
    unsigned voffA[2], voffB[2];
#pragma unroll
    for (int i = 0; i < 2; ++i) { int R, C; stage_rc(tid * 16 + i * 8192, R, C); const int Rb = Epi::PERM ? ((R & ~31) + perm32(R & 31)) : R;
        voffA[i] = (unsigned)(R * K + C) * 2u; voffB[i] = (unsigned)(Rb * K + C) * 2u; }
    const size_t kstep = (size_t)(BK * 2);
    const size_t hstep = (size_t)HALF * K * 2;
    const size_t tstep = 2 * hstep;
    const unsigned ldsw = (unsigned)wid * 1024u;
    const int aoff = lds_byte(wr * 64 + fr, fq * 8), boff = lds_byte(wc * 32 + fr, fq * 8);
#define PG8_SA(b, h) (((b) * 2 + (h)) * HTB)
#define PG8_SB(b, h) ((4 + (b) * 2 + (h)) * HTB)
#define PG8_STAGE(bufoff, gbase, voff) do { _Pragma("unroll") for (int _i = 0; _i < 2; ++_i) \
        __builtin_amdgcn_global_load_lds((const unsigned*)((const char*)(gbase) + (voff)[_i]), (PG8_LAS unsigned*)(lds + (bufoff) + ldsw + _i * 8192), 16, 0, 0); } while (0)
#define PG8_LDA(dst, b, h) do { _Pragma("unroll") for (int m = 0; m < 4; ++m) _Pragma("unroll") for (int k = 0; k < 2; ++k) dst[m][k] = *(const PG8_LAS bf16x8*)(lds + PG8_SA(b, h) + aoff + m * 2048 + k * 1024); } while (0)
#define PG8_LDB(dst, b, h) do { _Pragma("unroll") for (int n = 0; n < 2; ++n) _Pragma("unroll") for (int k = 0; k < 2; ++k) dst[n][k] = *(const PG8_LAS bf16x8*)(lds + PG8_SB(b, h) + boff + n * 2048 + k * 1024); } while (0)
#define PG8_MMA(ai, bj, At, Bt) do { __builtin_amdgcn_s_setprio(1); _Pragma("unroll") for (int m = 0; m < 4; ++m) _Pragma("unroll") for (int n = 0; n < 2; ++n) _Pragma("unroll") for (int k = 0; k < 2; ++k) \
        acc[ai][bj][m][n] = __builtin_amdgcn_mfma_f32_16x16x32_bf16(Bt[n][k], At[m][k], acc[ai][bj][m][n], 0, 0, 0); __builtin_amdgcn_s_setprio(0); } while (0)
#define PG8_WAIT_V(n) asm volatile("s_waitcnt vmcnt(" #n ")" ::: "memory")
#define PG8_WAIT_L(n) asm volatile("s_waitcnt lgkmcnt(" #n ")" ::: "memory")
#define PG8_BAR __builtin_amdgcn_s_barrier()
#define PG8_SCHED __builtin_amdgcn_sched_barrier(0)
    Unit cur, nxt; int ui = 0;
    if (!S.next(0, cur)) return;
    f32x4 acc[2][2][4][2];
#pragma unroll
    for (int a = 0; a < 2; ++a)
#pragma unroll
        for (int b = 0; b < 2; ++b)
#pragma unroll
            for (int m = 0; m < 4; ++m)
#pragma unroll
                for (int n = 0; n < 2; ++n) acc[a][b][m][n] = (f32x4){0.f, 0.f, 0.f, 0.f};
    bf16x8 At[4][2], B0[2][2], B1[2][2];
    const char* cA = (const char*)g.A + (size_t)cur.pm * tstep + (size_t)cur.k0 * kstep; const char* cB = (const char*)g.Bt + (size_t)cur.pn * tstep + (size_t)cur.k0 * kstep;
    S.a_ready(cur);
    if constexpr (SP2) {
        PG8_STAGE(PG8_SB(0, 0), cB, voffB); PG8_STAGE(PG8_SB(0, 1), cB + hstep, voffB); PG8_STAGE(PG8_SA(0, 0), cA, voffA); PG8_STAGE(PG8_SA(0, 1), cA + hstep, voffA);
        if (wr == 1) PG8_BAR;
        PG8_WAIT_V(2); PG8_BAR;
        PG8_STAGE(PG8_SB(1, 0), cB + kstep, voffB); PG8_STAGE(PG8_SA(1, 0), cA + kstep, voffA); PG8_STAGE(PG8_SB(1, 1), cB + hstep + kstep, voffB);
        PG8_WAIT_V(6); PG8_BAR;
    } else {
        PG8_STAGE(PG8_SB(0, 0), cB, voffB); PG8_STAGE(PG8_SA(0, 0), cA, voffA); PG8_STAGE(PG8_SB(0, 1), cB + hstep, voffB); PG8_STAGE(PG8_SA(0, 1), cA + hstep, voffA);
        if (wr == 1) PG8_BAR;
        PG8_WAIT_V(4); PG8_BAR;
        PG8_STAGE(PG8_SB(1, 0), cB + kstep, voffB); PG8_STAGE(PG8_SA(1, 0), cA + kstep, voffA); PG8_STAGE(PG8_SB(1, 1), cB + hstep + kstep, voffB);
        PG8_WAIT_V(6); PG8_BAR;
    }
    for (;;) {
        const bool has_next = S.next(ui + 1, nxt);
        const char* nA = has_next ? (const char*)g.A + (size_t)nxt.pm * tstep + (size_t)nxt.k0 * kstep : cA; const char* nB = has_next ? (const char*)g.Bt + (size_t)nxt.pn * tstep + (size_t)nxt.k0 * kstep : cB;
        const int nt = cur.nk;
        for (int t = 0; t < nt; t += 2) {
            const bool last = (t == nt - 2);
            const char* a1 = cA + (size_t)(t + 1) * kstep;
            const char* a2 = last ? nA : cA + (size_t)(t + 2) * kstep; const char* b2 = last ? nB : cB + (size_t)(t + 2) * kstep;
            const char* a3 = a2 + kstep; const char* b3 = b2 + kstep;
            if (last && has_next) S.a_ready(nxt);
            if constexpr (SP2) {
            PG8_LDB(B0, 0, 0); PG8_LDB(B1, 0, 1); PG8_SCHED; PG8_LDA(At, 0, 0); PG8_STAGE(PG8_SA(1, 1), a1 + hstep, voffA);
            PG8_WAIT_V(8); PG8_WAIT_L(0); PG8_BAR; PG8_MMA(0, 0, At, B0); PG8_MMA(0, 1, At, B1); PG8_BAR; PG8_SCHED;
            PG8_LDA(At, 0, 1); PG8_STAGE(PG8_SB(0, 0), b2, voffB); PG8_STAGE(PG8_SB(0, 1), b2 + hstep, voffB); PG8_STAGE(PG8_SA(0, 0), a2, voffA);
            PG8_WAIT_V(8); PG8_WAIT_L(0); PG8_BAR; PG8_MMA(1, 0, At, B0); PG8_MMA(1, 1, At, B1); PG8_BAR; PG8_SCHED;
            PG8_LDB(B0, 1, 0); PG8_LDB(B1, 1, 1); PG8_SCHED; PG8_LDA(At, 1, 0); PG8_STAGE(PG8_SA(0, 1), a2 + hstep, voffA);
            PG8_WAIT_V(8); PG8_WAIT_L(0); PG8_BAR; PG8_MMA(0, 0, At, B0); PG8_MMA(0, 1, At, B1); PG8_BAR; PG8_SCHED;
            PG8_LDA(At, 1, 1); PG8_STAGE(PG8_SB(1, 0), b3, voffB); PG8_STAGE(PG8_SB(1, 1), b3 + hstep, voffB); PG8_STAGE(PG8_SA(1, 0), a3, voffA);
            PG8_WAIT_V(8); PG8_WAIT_L(0); PG8_BAR; PG8_MMA(1, 0, At, B0); PG8_MMA(1, 1, At, B1); PG8_BAR; PG8_SCHED;
            } else {
            PG8_LDB(B0, 0, 0); PG8_SCHED; PG8_LDA(At, 0, 0); PG8_STAGE(PG8_SA(1, 1), a1 + hstep, voffA);
            PG8_WAIT_L(8); PG8_BAR; PG8_WAIT_L(0); PG8_MMA(0, 0, At, B0); PG8_BAR; PG8_SCHED;
            PG8_LDB(B1, 0, 1); PG8_STAGE(PG8_SB(0, 0), b2, voffB);
            PG8_BAR; PG8_WAIT_L(0); PG8_MMA(0, 1, At, B1); PG8_BAR;
            PG8_LDA(At, 0, 1); PG8_STAGE(PG8_SA(0, 0), a2, voffA);
            PG8_BAR; PG8_WAIT_L(0); PG8_MMA(1, 0, At, B0); PG8_BAR; PG8_SCHED;
            PG8_STAGE(PG8_SB(0, 1), b2 + hstep, voffB);
            PG8_WAIT_V(6); PG8_BAR; PG8_MMA(1, 1, At, B1); PG8_BAR;
            PG8_LDB(B0, 1, 0); PG8_SCHED; PG8_LDA(At, 1, 0); PG8_STAGE(PG8_SA(0, 1), a2 + hstep, voffA);
            PG8_WAIT_L(8); PG8_BAR; PG8_WAIT_L(0); PG8_MMA(0, 0, At, B0); PG8_BAR; PG8_SCHED;
            PG8_LDB(B1, 1, 1); PG8_STAGE(PG8_SB(1, 0), b3, voffB);
            PG8_BAR; PG8_WAIT_L(0); PG8_MMA(0, 1, At, B1); PG8_BAR;
            PG8_LDA(At, 1, 1); PG8_STAGE(PG8_SA(1, 0), a3, voffA);
            PG8_BAR; PG8_WAIT_L(0); PG8_MMA(1, 0, At, B0); PG8_BAR; PG8_SCHED;
            PG8_STAGE(PG8_SB(1, 1), b3 + hstep, voffB);
            PG8_WAIT_V(6); PG8_BAR; PG8_MMA(1, 1, At, B1); PG8_BAR;
            }
        }
        if constexpr (ALIGN_EPI) { if (wr == 0) PG8_BAR; }
        if constexpr (!Epi::AFTER_DRAIN) { E(acc, cur, wr, wc, fr, fq); S.done(cur); }
        if (!has_next) break;
#pragma unroll
        for (int a = 0; a < 2; ++a)
#pragma unroll
            for (int b = 0; b < 2; ++b)
#pragma unroll
                for (int m = 0; m < 4; ++m)
#pragma unroll
                    for (int n = 0; n < 2; ++n) acc[a][b][m][n] = (f32x4){0.f, 0.f, 0.f, 0.f};
        cur = nxt; cA = nA; cB = nB; ++ui;
        if constexpr (ALIGN_EPI) { if (wr == 1) PG8_BAR; }
    }
    PG8_WAIT_V(0);
    if constexpr (!ALIGN_EPI) { if (wr == 0) PG8_BAR; }
    PG8_BAR;
    if constexpr (Epi::AFTER_DRAIN) { E.fused(acc, cur, wr, wc, fr, fq, lds, wid, lane); S.done(cur); }
#undef PG8_SA
#undef PG8_SB
#undef PG8_STAGE
#undef PG8_LDA
#undef PG8_LDB
#undef PG8_MMA
#undef PG8_WAIT_V
#undef PG8_WAIT_L
#undef PG8_BAR
#undef PG8_SCHED
}

struct SplitOrder {
    int G, c, nkf;
    __host__ __device__ void init(int G_, int c_, int K) { G = G_; c = c_; nkf = K / BK; }
    __host__ __device__ bool next(int i, Unit& u) const {
        const int L = i * G + c;
        if (L < 256) { const int xcd = L % NXCD, off = L / NXCD, w = xcd * 32 + off; u.pm = (w / 32) * WGM + (w % 32) % WGM; u.pn = (w % 32) / WGM; u.k0 = 0; u.nk = nkf; u.part = -1; return true; }
        const int s = L - 256; if (s >= 64) return false;
        const int tile = s >> 2, sp = s & 3, pairs = nkf / 2, base = pairs / 4, rem = pairs % 4;
        u.pm = 64 + (tile >> 2); u.pn = tile & 3; u.k0 = 2 * (sp * base + (sp < rem ? sp : rem)); u.nk = 2 * (base + (sp < rem ? 1 : 0)); u.part = sp; return true;
    }
    __device__ __forceinline__ void a_ready(const Unit&) const {}
    __device__ __forceinline__ void done(const Unit&) const {}
};
}

#include <hip/hip_cooperative_groups.h>
namespace cg = cooperative_groups;

#define GAS __attribute__((address_space(1)))
#define LAS __attribute__((address_space(3)))
typedef unsigned short bf16;
typedef unsigned v4u __attribute__((ext_vector_type(4)));
typedef unsigned v2u __attribute__((ext_vector_type(2)));
typedef float f32x4 __attribute__((ext_vector_type(4)));
typedef float f32x2 __attribute__((ext_vector_type(2)));
typedef float f32x16 __attribute__((ext_vector_type(16)));
typedef short bf16x8 __attribute__((ext_vector_type(8)));
typedef short s16x4 __attribute__((ext_vector_type(4)));
typedef __bf16 bf16x2_t __attribute__((ext_vector_type(2)));

#ifndef MK_N_LAUNCHES
#define MK_N_LAUNCHES 1
#endif

constexpr int NWAVES = 8, NTHR = 512;
constexpr int D = 1024, TP = 16384, TS = 1024, T = TP + TS, SEQ = 4096, NB = 4, DB = 128, DL = 8;
constexpr int FF = 2816, ZP = 2816;
constexpr int ZK = 512, ZV = 640, ZHQ = 768, ZHF = 1280, ZHI = 1792, ZHG = 2304;
constexpr float EPS = 1e-6f;
constexpr int NPH = 13;

constexpr size_t MiB = 1u << 20;
constexpr size_t WS_WGU1 = 1 * MiB, WS_WD1 = 12 * MiB, WS_WIN = 17 * MiB + 512 * 1024, WS_WOUT = 23 * MiB, WS_WGU2 = 25 * MiB, WS_WD2 = 36 * MiB;
constexpr size_t WS_DEC = 42 * MiB, WS_XN = 43 * MiB, WS_HID = 77 * MiB, WS_Y = 171 * MiB, WS_PART = 239 * MiB, WS_END = 255 * MiB;
constexpr size_t CTL_ZERO_BYTES = 65536; constexpr int CW_BAR = 4096;
constexpr int MISC_OFF = 147456 - 64;
constexpr size_t OFF_KWP = (size_t)T * D, OFF_VWP = OFF_KWP + 65536, OFF_SP = OFF_VWP + 65536, OFF_KWS = OFF_SP + 262144, OFF_VWS = OFF_KWS + 2097152, OFF_SS = OFF_VWS + 2097152;
constexpr int LDS_BYTES = 147456;

#define MFMA32(a, b, c) __builtin_amdgcn_mfma_f32_32x32x16_bf16((a), (b), (c), 0, 0, 0)

__device__ __forceinline__ float bf2f(unsigned u) { return __uint_as_float(u << 16); }
__device__ __forceinline__ unsigned cvtpk(float lo, float hi) { f32x2 v = {lo, hi}; bf16x2_t b = __builtin_convertvector(v, bf16x2_t); return __builtin_bit_cast(unsigned, b); }
__device__ __forceinline__ float wave_sum(float v) {
#pragma unroll
    for (int o = 1; o < 64; o <<= 1) v += __shfl_xor(v, o);
    return v;
}
__device__ __forceinline__ float sigmoidf_(float x) { return __builtin_amdgcn_rcpf(1.f + __expf(-x)); }
__device__ __forceinline__ float siluf_(float x) { return x * sigmoidf_(x); }
__device__ __forceinline__ int crow(int reg, int h) { return (reg & 3) + 8 * (reg >> 2) + 4 * h; }

struct EpiSwiGLU {
    static constexpr bool PERM = true, AFTER_DRAIN = false;
    bf16* O; int ldo;
    __device__ __forceinline__ void operator()(const pg8::f32x4 (&acc)[2][2][4][2], const pg8::Unit& u, int wr, int wc, int fr, int fq) const {
        const int row0 = u.pm * 256 + wr * 64 + fr, j0 = u.pn * 128 + wc * 16 + 4 * fq;
#pragma unroll
        for (int ai = 0; ai < 2; ++ai)
#pragma unroll
            for (int m = 0; m < 4; ++m) { bf16* rowp = O + (size_t)(row0 + ai * 128 + m * 16) * ldo + j0;
#pragma unroll
                for (int bj = 0; bj < 2; ++bj) { const pg8::f32x4 v0 = acc[ai][bj][m][0], v1 = acc[ai][bj][m][1];
                    const float h0 = siluf_(v0[0]) * v0[1], h1 = siluf_(v0[2]) * v0[3], h2 = siluf_(v1[0]) * v1[1], h3 = siluf_(v1[2]) * v1[3];
                    v2u w; w.x = cvtpk(h0, h1); w.y = cvtpk(h2, h3);
                    *(v2u*)(rowp + bj * 64) = w; } }
    }
};
struct EpiF32 {
    static constexpr bool PERM = false, AFTER_DRAIN = false;
    float* O; int ldc; float* P;
    __device__ __forceinline__ void operator()(const pg8::f32x4 (&acc)[2][2][4][2], const pg8::Unit& u, int wr, int wc, int fr, int fq) const {
        int row0 = u.pm * 256 + wr * 64 + fr; const int col0 = u.pn * 256 + wc * 32 + 4 * fq; float* base = O;
        if (u.part >= 0) { row0 -= 16384; base = P + (size_t)u.part * (1024 * 1024); }
#pragma unroll
        for (int ai = 0; ai < 2; ++ai)
#pragma unroll
            for (int m = 0; m < 4; ++m) { float* rowp = base + (size_t)(row0 + ai * 128 + m * 16) * ldc + col0;
#pragma unroll
                for (int bj = 0; bj < 2; ++bj)
#pragma unroll
                    for (int n = 0; n < 2; ++n) *(pg8::f32x4*)(rowp + bj * 128 + n * 16) = acc[ai][bj][m][n]; }
    }
};

__device__ __forceinline__ void transpose_item(const float* W, int K, int N, bf16* WT, int split, int mul, LAS float* scr, int item, int lane) {
    const int nblk = N / 64, kb = item / nblk, nb = item % nblk, k0 = 64 * kb, n0 = 64 * nb, kr = lane >> 4, n4 = (lane & 15) * 4;
    f32x4 v[16];
#pragma unroll
    for (int i = 0; i < 16; ++i) v[i] = *(const f32x4*)(W + (size_t)(k0 + 4 * i + kr) * N + n0 + n4);
#pragma unroll
    for (int i = 0; i < 16; ++i) { LAS float* s = scr + (4 * i + kr) * 65 + n4; s[0] = v[i].x; s[1] = v[i].y; s[2] = v[i].z; s[3] = v[i].w; }
    asm volatile("s_waitcnt lgkmcnt(0)" ::: "memory");
    const int c = lane & 7, part = n0 / split, nbase = n0 - part * split;
#pragma unroll
    for (int j = 0; j < 8; ++j) { const int n = (lane >> 3) + 8 * j; const LAS float* s = scr + (8 * c) * 65 + n;
        v4u o; o.x = cvtpk(s[0 * 65], s[1 * 65]); o.y = cvtpk(s[2 * 65], s[3 * 65]); o.z = cvtpk(s[4 * 65], s[5 * 65]); o.w = cvtpk(s[6 * 65], s[7 * 65]);
        *(v4u*)(WT + (size_t)((nbase + n) * mul + part) * K + k0 + 8 * c) = o; }
    asm volatile("s_waitcnt lgkmcnt(0)" ::: "memory");
}
__device__ __forceinline__ void rms_row_bf16(const float* xrow, const float* g, bf16* orow, int lane) {
    f32x4 v[4]; float s = 0.f;
#pragma unroll
    for (int j = 0; j < 4; ++j) { v[j] = ((const f32x4*)xrow)[lane + 64 * j]; s += (v[j].x * v[j].x + v[j].y * v[j].y) + (v[j].z * v[j].z + v[j].w * v[j].w); }
    const float r = rsqrtf(wave_sum(s) * (1.f / D) + EPS);
#pragma unroll
    for (int j = 0; j < 4; ++j) { const f32x4 gg = ((const f32x4*)g)[lane + 64 * j]; const f32x4 o = v[j] * gg * r;
        v2u w; w.x = cvtpk(o.x, o.y); w.y = cvtpk(o.z, o.w); ((v2u*)orow)[lane + 64 * j] = w; }
}
__device__ __forceinline__ void row_update(const float* xin, const float* y, int nparts, const float* gpost, float coef, float* xout, const float* gnext, bf16* xn, int lane) {
    f32x4 yv[4], xv[4]; float s = 0.f;
#pragma unroll
    for (int j = 0; j < 4; ++j) { yv[j] = ((const f32x4*)y)[lane + 64 * j];
        if (nparts > 1) {
#pragma unroll
            for (int p = 1; p < 4; ++p) yv[j] += ((const f32x4*)(y + (size_t)p * (1024 * 1024)))[lane + 64 * j]; }
        s += (yv[j].x * yv[j].x + yv[j].y * yv[j].y) + (yv[j].z * yv[j].z + yv[j].w * yv[j].w); }
#pragma unroll
    for (int j = 0; j < 4; ++j) xv[j] = ((const f32x4*)xin)[lane + 64 * j];
    const float r = rsqrtf(wave_sum(s) * (1.f / D) + EPS) * coef;
    float s2 = 0.f;
#pragma unroll
    for (int j = 0; j < 4; ++j) { const f32x4 gg = ((const f32x4*)gpost)[lane + 64 * j]; xv[j] = xv[j] + yv[j] * gg * r;
        s2 += (xv[j].x * xv[j].x + xv[j].y * xv[j].y) + (xv[j].z * xv[j].z + xv[j].w * xv[j].w); ((f32x4*)xout)[lane + 64 * j] = xv[j]; }
    if (xn) {
        const float r2 = rsqrtf(wave_sum(s2) * (1.f / D) + EPS);
#pragma unroll
        for (int j = 0; j < 4; ++j) { const f32x4 gg = ((const f32x4*)gnext)[lane + 64 * j]; const f32x4 o = xv[j] * gg * r2;
            v2u w; w.x = cvtpk(o.x, o.y); w.y = cvtpk(o.z, o.w); ((v2u*)xn)[lane + 64 * j] = w; }
    }
}

constexpr int KSB = 144, VPB = 528;
__device__ __forceinline__ void attn_core(const LAS unsigned char* Ks, const LAS unsigned char* Vt, const bf16* qptr, bf16* optr, int kbase, int lo, int hi, float sink, int r, int h) {
    bf16x8 qf[4];
#pragma unroll
    for (int s = 0; s < 4; ++s) qf[s] = *(const bf16x8*)(qptr + 16 * s + 8 * h);
    f32x16 st[5];
#pragma unroll
    for (int kt = 0; kt < 5; ++kt) {
#pragma unroll
        for (int i = 0; i < 16; ++i) st[kt][i] = 0.f;
#pragma unroll
        for (int s = 0; s < 4; ++s) { const bf16x8 kf = *(const LAS bf16x8*)(Ks + (kbase + 32 * kt + r) * KSB + (16 * s + 8 * h) * 2); st[kt] = MFMA32(kf, qf[s], st[kt]); }
    }
    float mx = sink;
#pragma unroll
    for (int kt = 0; kt < 5; ++kt)
#pragma unroll
        for (int i = 0; i < 16; ++i) { const int j = kbase + 32 * kt + crow(i, h); const float v = (j >= lo && j <= hi) ? st[kt][i] * 0.125f : -INFINITY; st[kt][i] = v; mx = fmaxf(mx, v); }
    mx = fmaxf(mx, __shfl_xor(mx, 32));
    float sum = 0.f;
#pragma unroll
    for (int kt = 0; kt < 5; ++kt)
#pragma unroll
        for (int i = 0; i < 16; ++i) { const float p = __expf(st[kt][i] - mx); st[kt][i] = p; sum += p; }
    sum += __shfl_xor(sum, 32);
    const float inv = 1.f / (sum + __expf(sink - mx));
    f32x16 o[2];
#pragma unroll
    for (int mt = 0; mt < 2; ++mt)
#pragma unroll
        for (int i = 0; i < 16; ++i) o[mt][i] = 0.f;
#pragma unroll
    for (int kt = 0; kt < 5; ++kt)
#pragma unroll
        for (int s2 = 0; s2 < 2; ++s2) {
            v4u pw; pw.x = cvtpk(st[kt][8 * s2 + 0], st[kt][8 * s2 + 1]); pw.y = cvtpk(st[kt][8 * s2 + 2], st[kt][8 * s2 + 3]); pw.z = cvtpk(st[kt][8 * s2 + 4], st[kt][8 * s2 + 5]); pw.w = cvtpk(st[kt][8 * s2 + 6], st[kt][8 * s2 + 7]);
            const bf16x8 pb = __builtin_bit_cast(bf16x8, pw);
#pragma unroll
            for (int mt = 0; mt < 2; ++mt) {
                const LAS unsigned char* vp = Vt + (32 * mt + r) * VPB + (kbase + 32 * kt + 16 * s2 + 4 * h) * 2;
                const s16x4 l4 = *(const LAS s16x4*)vp, h4 = *(const LAS s16x4*)(vp + 16);
                const bf16x8 va = __builtin_shufflevector(l4, h4, 0, 1, 2, 3, 4, 5, 6, 7);
                o[mt] = MFMA32(va, pb, o[mt]);
            }
        }
#pragma unroll
    for (int mt = 0; mt < 2; ++mt)
#pragma unroll
        for (int i4 = 0; i4 < 4; ++i4) { v2u w; w.x = cvtpk(o[mt][4 * i4] * inv, o[mt][4 * i4 + 1] * inv); w.y = cvtpk(o[mt][4 * i4 + 2] * inv, o[mt][4 * i4 + 3] * inv);
            *(v2u*)(optr + 32 * mt + 8 * i4 + 4 * h) = w; }
}

#define XB_TMO      128
#define XB_XCNT(j)  (256  + 64 * (j))
#define XB_XSUB(j)  (1280 + 64 * (j))
#define XB_XGEN(j)  (2304 + 64 * (j))
#define XB_TOP      3328
#define XB_TOPGEN   3392
#define XCD_BAR_WORDS 3456
#define XB_SPIN_CAP (1u << 18)

__device__ __forceinline__ unsigned xb_ld(unsigned* p)              { return __hip_atomic_load(p, __ATOMIC_RELAXED, __HIP_MEMORY_SCOPE_AGENT); }
__device__ __forceinline__ unsigned xb_add(unsigned* p, unsigned v) { return __hip_atomic_fetch_add(p, v, __ATOMIC_RELAXED, __HIP_MEMORY_SCOPE_AGENT); }
__device__ __forceinline__ unsigned xb_xcc_id() { return (unsigned)__builtin_amdgcn_s_getreg((3 << 11) | 20) & 0xFu; }
#define XB_SPIN(cond, bar) do { unsigned _sp = 0; while (cond) { __builtin_amdgcn_s_sleep(1); \
    if ((++_sp & 255u) == 0u) { if (xb_ld(&(bar)[XB_TMO])) break; if (_sp > XB_SPIN_CAP) { atomicAdd(&(bar)[XB_TMO], 1u); break; } } } } while (0)

struct XcdBarrier {
    unsigned* bar; unsigned x;
    volatile LAS unsigned* st;
};

__device__ __forceinline__ XcdBarrier xcd_barrier_post(unsigned* bar, volatile LAS unsigned* st) {
    XcdBarrier b; b.bar = bar; b.x = xb_xcc_id(); b.st = st;
    if (threadIdx.x == 0) (void)xb_add(&bar[XB_XCNT(b.x)], 1u);
    return b;
}
__device__ __forceinline__ void xcd_barrier_complete(unsigned* bar, unsigned x, unsigned& nloc, unsigned& nx) {
    const unsigned G = gridDim.x * gridDim.y * gridDim.z;
    unsigned sum, cnt, mine, sp = 0u;
    for (;;) {
        sum = 0u; cnt = 0u; mine = 0u;
#pragma unroll
        for (unsigned j = 0; j < 16; ++j) { const unsigned c = xb_ld(&bar[XB_XCNT(j)]); sum += c; cnt += (c > 0u) ? 1u : 0u; mine = (j == x) ? c : mine; }
        if (sum == G) break;
        __builtin_amdgcn_s_sleep(1);
        if ((++sp & 255u) == 0u) { if (xb_ld(&bar[XB_TMO])) break; if (sp > XB_SPIN_CAP) { atomicAdd(&bar[XB_TMO], 1u); break; } }
    }
    nloc = mine > 0u ? mine : 1u; nx = cnt > 0u ? cnt : 1u;
}

__device__ __forceinline__ void xcd_barrier(const XcdBarrier& b) {
    asm volatile("s_waitcnt vmcnt(0)" ::: "memory");
    __syncthreads();
    if (threadIdx.x == 0) {
        unsigned* bar = b.bar;
        __builtin_amdgcn_s_waitcnt(0);
        unsigned nloc = b.st[0], nx = b.st[1];
        if (nloc == 0u) { xcd_barrier_complete(bar, b.x, nloc, nx); b.st[0] = nloc; b.st[1] = nx; }
        const unsigned old = xb_add(&bar[XB_XSUB(b.x)], 1u);
        const unsigned gen = old / nloc;
        if (old + 1u == (gen + 1u) * nloc) {
            __builtin_amdgcn_fence(__ATOMIC_RELEASE, "agent");
            asm volatile("s_waitcnt vmcnt(0)" ::: "memory");
            const unsigned og = xb_add(&bar[XB_TOP], 1u);
            const unsigned tg = og / nx;
            if (og + 1u == (tg + 1u) * nx) xb_add(&bar[XB_TOPGEN], 1u);
            else XB_SPIN(xb_ld(&bar[XB_TOPGEN]) == tg, bar);
            __builtin_amdgcn_fence(__ATOMIC_ACQUIRE, "agent");
            xb_add(&bar[XB_XGEN(b.x)], 1u);
            asm volatile("s_waitcnt vmcnt(0)" ::: "memory");
        } else {
            XB_SPIN(xb_ld(&bar[XB_XGEN(b.x)]) == gen, bar);
            __builtin_amdgcn_fence(__ATOMIC_ACQUIRE, "agent");
            asm volatile("s_waitcnt vmcnt(0)" ::: "memory");
        }
    }
    __syncthreads();
}

struct Ctx {
    const float* in[22]; float* out; unsigned char* ws;
    bf16 *XN, *HID, *MIX; float *Y, *SLOC, *DEC;
    int tid, lane, wave;
};

__device__ __forceinline__ void attn_prompt_item(const Ctx& C, LAS unsigned char* lds, int item) {
    const int kvh = item & 1, n = (item >> 1) & 31, b = item >> 6;
    LAS unsigned char* Ks = lds; LAS unsigned char* Vt = lds + 256 * KSB;
    const bf16* Z = C.HID;
    {
        const int key = C.tid >> 1, dh = C.tid & 1, tok = (n - 1) * 128 + key;
        v4u kv[4], vv[4];
        if (tok >= 0) { const bf16* zr = Z + (size_t)(b * SEQ + tok) * ZP + kvh * 64 + dh * 32;
#pragma unroll
            for (int j = 0; j < 4; ++j) { kv[j] = *(const v4u*)(zr + ZK + 8 * j); vv[j] = *(const v4u*)(zr + ZV + 8 * j); }
        } else {
#pragma unroll
            for (int j = 0; j < 4; ++j) { kv[j] = (v4u){0u, 0u, 0u, 0u}; vv[j] = (v4u){0u, 0u, 0u, 0u}; }
        }
#pragma unroll
        for (int j = 0; j < 4; ++j) *(LAS v4u*)(Ks + key * KSB + dh * 64 + 16 * j) = kv[j];
#pragma unroll
        for (int j = 0; j < 4; ++j)
#pragma unroll
            for (int e = 0; e < 4; ++e) { const unsigned w = vv[j][e]; const int d = dh * 32 + 8 * j + 2 * e;
                *(LAS unsigned short*)(Vt + d * VPB + key * 2) = (unsigned short)(w & 0xffffu); *(LAS unsigned short*)(Vt + (d + 1) * VPB + key * 2) = (unsigned short)(w >> 16); }
        if (n == 31 && key >= 128) {
            float* ko = C.out + OFF_KWP + ((size_t)(b * 128 + key - 128) * 2 + kvh) * 64 + dh * 32; float* vo = C.out + OFF_VWP + ((size_t)(b * 128 + key - 128) * 2 + kvh) * 64 + dh * 32;
#pragma unroll
            for (int j = 0; j < 4; ++j) {
                *(f32x4*)(ko + 8 * j) = (f32x4){bf2f(kv[j][0] & 0xffffu), bf2f(kv[j][0] >> 16), bf2f(kv[j][1] & 0xffffu), bf2f(kv[j][1] >> 16)};
                *(f32x4*)(ko + 8 * j + 4) = (f32x4){bf2f(kv[j][2] & 0xffffu), bf2f(kv[j][2] >> 16), bf2f(kv[j][3] & 0xffffu), bf2f(kv[j][3] >> 16)};
                *(f32x4*)(vo + 8 * j) = (f32x4){bf2f(vv[j][0] & 0xffffu), bf2f(vv[j][0] >> 16), bf2f(vv[j][1] & 0xffffu), bf2f(vv[j][1] >> 16)};
                *(f32x4*)(vo + 8 * j + 4) = (f32x4){bf2f(vv[j][2] & 0xffffu), bf2f(vv[j][2] >> 16), bf2f(vv[j][3] & 0xffffu), bf2f(vv[j][3] >> 16)}; }
        }
    }
    __syncthreads();
    const int g = C.wave >> 1, qh = C.wave & 1, r = C.lane & 31, h = C.lane >> 5;
    const float sink = C.in[7][kvh * 4 + g];
#pragma unroll 1
    for (int sb = 0; sb < 2; ++sb) {
        const int q0 = 64 * qh + 32 * sb, qi = q0 + r; const size_t row = (size_t)(b * SEQ + n * 128 + qi);
        attn_core(Ks, Vt, Z + row * ZP + kvh * 256 + g * 64, C.MIX + row * D + kvh * 256 + g * 64, q0, (n == 0) ? 128 : qi, qi + 128, sink, r, h);
    }
    __syncthreads();
}
__device__ __forceinline__ void attn_sample_item(const Ctx& C, LAS unsigned char* lds, int item) {
    const int kvh = item & 1, b = item >> 1;
    LAS unsigned char* Ks = lds; LAS unsigned char* Vt = lds + 256 * KSB;
    const bf16* Z = C.HID; const float* ck = C.in[2]; const float* cv = C.in[3];
    for (int idx = C.tid; idx < 160 * 16; idx += NTHR) {
        const int j = idx >> 4, d4 = (idx & 15) * 4;
        f32x4 kf = {0.f, 0.f, 0.f, 0.f}, vf = {0.f, 0.f, 0.f, 0.f};
        if (j < 128) { const size_t o = ((size_t)(b * 128 + j) * 2 + kvh) * 64 + d4; kf = *(const f32x4*)(ck + o); vf = *(const f32x4*)(cv + o); }
        else if (j < 136) { const bf16* zr = Z + (size_t)(TP + b * DL + j - 128) * ZP + kvh * 64 + d4; const v2u kw = *(const v2u*)(zr + ZK), vw = *(const v2u*)(zr + ZV);
            kf = (f32x4){bf2f(kw.x & 0xffffu), bf2f(kw.x >> 16), bf2f(kw.y & 0xffffu), bf2f(kw.y >> 16)}; vf = (f32x4){bf2f(vw.x & 0xffffu), bf2f(vw.x >> 16), bf2f(vw.y & 0xffffu), bf2f(vw.y >> 16)}; }
        if (j >= 8 && j < 136) { const size_t o = ((size_t)(b * 128 + j - 8) * 2 + kvh) * 64 + d4; *(f32x4*)(C.out + OFF_KWS + o) = kf; *(f32x4*)(C.out + OFF_VWS + o) = vf; }
        v2u kw; kw.x = cvtpk(kf.x, kf.y); kw.y = cvtpk(kf.z, kf.w); *(LAS v2u*)(Ks + j * KSB + d4 * 2) = kw;
        const unsigned v01 = cvtpk(vf.x, vf.y), v23 = cvtpk(vf.z, vf.w);
        *(LAS unsigned short*)(Vt + (d4 + 0) * VPB + j * 2) = (unsigned short)(v01 & 0xffffu); *(LAS unsigned short*)(Vt + (d4 + 1) * VPB + j * 2) = (unsigned short)(v01 >> 16);
        *(LAS unsigned short*)(Vt + (d4 + 2) * VPB + j * 2) = (unsigned short)(v23 & 0xffffu); *(LAS unsigned short*)(Vt + (d4 + 3) * VPB + j * 2) = (unsigned short)(v23 >> 16);
    }
    __syncthreads();
    if (C.wave == 0) {
        const int r = C.lane & 31, h = C.lane >> 5, g = r >> 3, i = r & 7; const size_t row = (size_t)(TP + b * DL + i);
        attn_core(Ks, Vt, Z + row * ZP + kvh * 256 + g * 64, C.MIX + row * D + kvh * 256 + g * 64, 0, i, 128 + i, C.in[7][kvh * 4 + g], r, h);
    }
    __syncthreads();
}

constexpr int TPB = 144;
constexpr int KQB = 272;
__device__ __forceinline__ void hgrn_local_item(const Ctx& C, LAS unsigned char* lds, int item) {
    const int c = item & 63, h = (item >> 6) & 3, b = item >> 8;
    const bf16* Z = C.HID + (size_t)(b * SEQ + c * 64) * ZP;
    LAS unsigned char* KtT = lds; LAS unsigned char* VT = lds + 128 * TPB; LAS float* segs = (LAS float*)(lds + 2 * 128 * TPB);
    const int seg = C.tid >> 7, k = C.tid & 127;
    const float l0 = C.in[9][h * 128 + k], l1 = C.in[9][512 + h * 128 + k], lb = sigmoidf_(l0 - l1);
    float G[16], kk[16]; float cum = 0.f; unsigned vraw[16];
#pragma unroll
    for (int e = 0; e < 16; ++e) { const bf16* zr = Z + (size_t)(seg * 16 + e) * ZP + h * 128 + k; const float hf = bf2f(zr[ZHF]); vraw[e] = zr[ZHI];
        const float sg = sigmoidf_(hf), f = lb + (1.f - lb) * sg; cum += __logf(f); G[e] = cum; kk[e] = 1.f - f; }
    segs[seg * 128 + k] = cum;
    __syncthreads();
    float off = 0.f, tot = 0.f;
#pragma unroll
    for (int s = 0; s < 4; ++s) { const float v = segs[s * 128 + k]; tot += v; if (s < seg) off += v; }
    {
        unsigned kw[8], vw[8];
#pragma unroll
        for (int e = 0; e < 8; ++e) { kw[e] = cvtpk(kk[2 * e] * __expf(tot - off - G[2 * e]), kk[2 * e + 1] * __expf(tot - off - G[2 * e + 1])); vw[e] = vraw[2 * e] | (vraw[2 * e + 1] << 16); }
        *(LAS v4u*)(KtT + k * TPB + seg * 32) = (v4u){kw[0], kw[1], kw[2], kw[3]}; *(LAS v4u*)(KtT + k * TPB + seg * 32 + 16) = (v4u){kw[4], kw[5], kw[6], kw[7]};
        *(LAS v4u*)(VT + k * TPB + seg * 32) = (v4u){vw[0], vw[1], vw[2], vw[3]}; *(LAS v4u*)(VT + k * TPB + seg * 32 + 16) = (v4u){vw[4], vw[5], vw[6], vw[7]};
    }
    if (seg == 0) C.DEC[(size_t)item * 128 + k] = __expf(tot);
    __syncthreads();
    const int r = C.lane & 31, h2 = C.lane >> 5, vt = C.wave >> 1;
    float* So = C.SLOC + (size_t)item * 16384;
#pragma unroll
    for (int kk2 = 0; kk2 < 2; ++kk2) {
        const int kt = (C.wave & 1) * 2 + kk2;
        f32x16 acc;
#pragma unroll
        for (int i = 0; i < 16; ++i) acc[i] = 0.f;
#pragma unroll
        for (int s = 0; s < 4; ++s) { const bf16x8 a = *(const LAS bf16x8*)(VT + (32 * vt + r) * TPB + (16 * s + 8 * h2) * 2), bb = *(const LAS bf16x8*)(KtT + (32 * kt + r) * TPB + (16 * s + 8 * h2) * 2);
            acc = MFMA32(a, bb, acc); }
#pragma unroll
        for (int i = 0; i < 16; ++i) So[(32 * vt + crow(i, h2)) * 128 + 32 * kt + r] = acc[i];
    }
    __syncthreads();
}
__device__ __forceinline__ void hgrn_out_item(const Ctx& C, LAS unsigned char* lds, int item) {
    const int c = item & 63, h = (item >> 6) & 3, b = item >> 8;
    const size_t row0 = (size_t)(b * SEQ + c * 64);
    const bf16* Z = C.HID + row0 * ZP;
    LAS unsigned char* Qt = lds; LAS unsigned char* Kt2 = lds + 64 * KQB; LAS unsigned char* VT = lds + 2 * 64 * KQB; LAS unsigned char* ST = VT + 128 * TPB;
    LAS float* segs = (LAS float*)(ST + 128 * KQB); LAS float* part = segs + 512;
    const int seg = C.tid >> 7, k = C.tid & 127;
    const float l0 = C.in[9][h * 128 + k], l1 = C.in[9][512 + h * 128 + k], lb = sigmoidf_(l0 - l1);
    float G[16], kk[16], qq[16]; float cum = 0.f; unsigned vraw[16];
#pragma unroll
    for (int e = 0; e < 16; ++e) { const bf16* zr = Z + (size_t)(seg * 16 + e) * ZP + h * 128 + k; const float hf = bf2f(zr[ZHF]); vraw[e] = zr[ZHI]; qq[e] = siluf_(bf2f(zr[ZHQ]));
        const float sg = sigmoidf_(hf), f = lb + (1.f - lb) * sg; cum += __logf(f); G[e] = cum; kk[e] = 1.f - f; }
    segs[seg * 128 + k] = cum;
    {
        const float* Ss = C.SLOC + (size_t)item * 16384;
#pragma unroll
        for (int j = 0; j < 8; ++j) { const int e = (j * NTHR + C.tid) * 4, v = e >> 7, k4 = e & 127; const f32x4 s4 = *(const f32x4*)(Ss + e);
            v2u w; w.x = cvtpk(s4.x, s4.y); w.y = cvtpk(s4.z, s4.w); *(LAS v2u*)(ST + v * KQB + k4 * 2) = w; }
    }
    __syncthreads();
    float off = 0.f;
#pragma unroll
    for (int s = 0; s < 4; ++s) { const float v = segs[s * 128 + k]; if (s < seg) off += v; }
    {
        unsigned vw[8];
#pragma unroll
        for (int e = 0; e < 16; ++e) { const float g = off + G[e]; const int t = seg * 16 + e;
            *(LAS unsigned short*)(Qt + t * KQB + k * 2) = (unsigned short)(cvtpk(qq[e] * __expf(g), 0.f) & 0xffffu);
            *(LAS unsigned short*)(Kt2 + t * KQB + k * 2) = (unsigned short)(cvtpk(kk[e] * __expf(-g), 0.f) & 0xffffu); }
#pragma unroll
        for (int e = 0; e < 8; ++e) vw[e] = vraw[2 * e] | (vraw[2 * e + 1] << 16);
        *(LAS v4u*)(VT + k * TPB + seg * 32) = (v4u){vw[0], vw[1], vw[2], vw[3]}; *(LAS v4u*)(VT + k * TPB + seg * 32 + 16) = (v4u){vw[4], vw[5], vw[6], vw[7]};
    }
    __syncthreads();
    const int r = C.lane & 31, h2 = C.lane >> 5, vt = C.wave >> 1, tt = C.wave & 1;
    bf16x8 qf[8];
#pragma unroll
    for (int ks = 0; ks < 8; ++ks) qf[ks] = *(const LAS bf16x8*)(Qt + (32 * tt + r) * KQB + (16 * ks + 8 * h2) * 2);
    f32x16 acc;
#pragma unroll
    for (int i = 0; i < 16; ++i) acc[i] = 0.f;
#pragma unroll
    for (int ks = 0; ks < 8; ++ks) { const bf16x8 a = *(const LAS bf16x8*)(ST + (32 * vt + r) * KQB + (16 * ks + 8 * h2) * 2); acc = MFMA32(a, qf[ks], acc); }
#pragma unroll
    for (int st = 0; st < 2; ++st) {
        if (st <= tt) {
            f32x16 X;
#pragma unroll
            for (int i = 0; i < 16; ++i) X[i] = 0.f;
#pragma unroll
            for (int ks = 0; ks < 8; ++ks) { const bf16x8 a = *(const LAS bf16x8*)(Kt2 + (32 * st + r) * KQB + (16 * ks + 8 * h2) * 2); X = MFMA32(a, qf[ks], X); }
#pragma unroll
            for (int i = 0; i < 16; ++i) { const int s = 32 * st + crow(i, h2), t = 32 * tt + r; X[i] = (s <= t) ? X[i] : 0.f; }
#pragma unroll
            for (int s2 = 0; s2 < 2; ++s2) {
                v4u pw; pw.x = cvtpk(X[8 * s2 + 0], X[8 * s2 + 1]); pw.y = cvtpk(X[8 * s2 + 2], X[8 * s2 + 3]); pw.z = cvtpk(X[8 * s2 + 4], X[8 * s2 + 5]); pw.w = cvtpk(X[8 * s2 + 6], X[8 * s2 + 7]);
                const bf16x8 pb = __builtin_bit_cast(bf16x8, pw);
                const LAS unsigned char* vp = VT + (32 * vt + r) * TPB + (32 * st + 16 * s2 + 4 * h2) * 2;
                const s16x4 l4 = *(const LAS s16x4*)vp, h4 = *(const LAS s16x4*)(vp + 16);
                acc = MFMA32(__builtin_shufflevector(l4, h4, 0, 1, 2, 3, 4, 5, 6, 7), pb, acc);
            }
        }
    }
    float ssq = 0.f;
#pragma unroll
    for (int i = 0; i < 16; ++i) ssq += acc[i] * acc[i];
    ssq += __shfl_xor(ssq, 32);
    if (h2 == 0) part[vt * 64 + 32 * tt + r] = ssq;
    __syncthreads();
    const int t = 32 * tt + r;
    const float tot = (part[t] + part[64 + t]) + (part[128 + t] + part[192 + t]);
    const float rinv = rsqrtf(tot * (1.f / 128.f) + EPS);
    const bf16* zg = Z + (size_t)t * ZP + ZHG + h * 128 + 32 * vt + 4 * h2;
    bf16* mo = C.MIX + (row0 + t) * D + 512 + h * 128 + 32 * vt + 4 * h2;
    const float* gn = C.in[10] + 32 * vt + 4 * h2;
#pragma unroll
    for (int i4 = 0; i4 < 4; ++i4) { const v2u gw = *(const v2u*)(zg + 8 * i4); const f32x4 gg = *(const f32x4*)(gn + 8 * i4);
        const float o0 = acc[4 * i4] * rinv * gg.x * siluf_(bf2f(gw.x & 0xffffu)), o1 = acc[4 * i4 + 1] * rinv * gg.y * siluf_(bf2f(gw.x >> 16));
        const float o2 = acc[4 * i4 + 2] * rinv * gg.z * siluf_(bf2f(gw.y & 0xffffu)), o3 = acc[4 * i4 + 3] * rinv * gg.w * siluf_(bf2f(gw.y >> 16));
        v2u w; w.x = cvtpk(o0, o1); w.y = cvtpk(o2, o3); *(v2u*)(mo + 8 * i4) = w; }
    __syncthreads();
}
__device__ __forceinline__ void hgrn_sample_item(const Ctx& C, LAS unsigned char* lds, int item) {
    const int h = item & 3, b = item >> 2;
    LAS float* fA = (LAS float*)lds; LAS float* kA = fA + 1024; LAS float* qA = kA + 1024; LAS float* vA = qA + 1024; LAS float* gA = vA + 1024; LAS float* part = gA + 1024;
    {
        const int t = C.tid >> 6, c2 = (C.tid & 63) * 2; const bf16* zr = C.HID + (size_t)(TP + b * DL + t) * ZP + h * 128 + c2;
        const unsigned wq = *(const unsigned*)(zr + ZHQ), wf = *(const unsigned*)(zr + ZHF), wi = *(const unsigned*)(zr + ZHI), wg = *(const unsigned*)(zr + ZHG);
#pragma unroll
        for (int e = 0; e < 2; ++e) { const int k = c2 + e; const float l0 = C.in[9][h * 128 + k], l1 = C.in[9][512 + h * 128 + k], lb = sigmoidf_(l0 - l1);
            const float hq = bf2f(e ? (wq >> 16) : (wq & 0xffffu)), hf = bf2f(e ? (wf >> 16) : (wf & 0xffffu)), hi = bf2f(e ? (wi >> 16) : (wi & 0xffffu)), hg = bf2f(e ? (wg >> 16) : (wg & 0xffffu));
            const float f = lb + (1.f - lb) * sigmoidf_(hf);
            fA[t * 128 + k] = f; kA[t * 128 + k] = 1.f - f; qA[t * 128 + k] = siluf_(hq); vA[t * 128 + k] = hi; gA[t * 128 + k] = siluf_(hg); }
    }
    __syncthreads();
    const int v4 = C.tid & 31, kg = C.tid >> 5;
    const float* S0 = C.in[4] + ((size_t)(b * 4 + h) * 128 + kg * 8) * 128 + v4 * 4;
    f32x4 S[8];
#pragma unroll
    for (int i = 0; i < 8; ++i) S[i] = *(const f32x4*)(S0 + i * 128);
#pragma unroll
    for (int t = 0; t < 8; ++t) {
        const f32x4 vv = *(const LAS f32x4*)(vA + t * 128 + v4 * 4); f32x4 po = {0.f, 0.f, 0.f, 0.f};
#pragma unroll
        for (int i = 0; i < 8; ++i) { const int k = kg * 8 + i; const float f = fA[t * 128 + k], kk = kA[t * 128 + k], q = qA[t * 128 + k]; S[i] = S[i] * f + vv * kk; po += S[i] * q; }
        *(LAS f32x4*)(part + (t * 16 + kg) * 128 + v4 * 4) = po;
    }
    float* So = C.out + OFF_SS + ((size_t)(b * 4 + h) * 128 + kg * 8) * 128 + v4 * 4;
#pragma unroll
    for (int i = 0; i < 8; ++i) *(f32x4*)(So + i * 128) = S[i];
    __syncthreads();
    {
        const int t = C.tid >> 6, c2 = (C.tid & 63) * 2; float o0 = 0.f, o1 = 0.f;
#pragma unroll
        for (int j = 0; j < 16; ++j) { const f32x2 p = *(const LAS f32x2*)(part + (t * 16 + j) * 128 + c2); o0 += p.x; o1 += p.y; }
        const float rinv = rsqrtf(wave_sum(o0 * o0 + o1 * o1) * (1.f / 128.f) + EPS);
        const float g0 = C.in[10][c2], g1 = C.in[10][c2 + 1];
        *(unsigned*)(C.MIX + (size_t)(TP + b * DL + t) * D + 512 + h * 128 + c2) = cvtpk(o0 * rinv * g0 * gA[t * 128 + c2], o1 * rinv * g1 * gA[t * 128 + c2 + 1]);
    }
    __syncthreads();
}

struct Args { const float* in[22]; float* out; unsigned char* ws; int ph_lo, ph_hi; };

__global__ void __launch_bounds__(NTHR, 2) fwd(Args args) {
    extern __shared__ __attribute__((aligned(16))) unsigned char lds_raw[];
    LAS unsigned char* lds = (LAS unsigned char*)lds_raw;
    Ctx C;
#pragma unroll
    for (int i = 0; i < 22; ++i) C.in[i] = args.in[i];
    C.out = args.out; C.ws = args.ws;
    C.XN = (bf16*)(args.ws + WS_XN); C.HID = (bf16*)(args.ws + WS_HID); C.MIX = C.XN; C.Y = (float*)(args.ws + WS_Y); C.SLOC = C.Y; C.DEC = (float*)(args.ws + WS_DEC);
    C.tid = threadIdx.x; C.lane = C.tid & 63; C.wave = __builtin_amdgcn_readfirstlane(C.tid >> 6);
    bf16* Wgu1 = (bf16*)(args.ws + WS_WGU1); bf16* Wd1 = (bf16*)(args.ws + WS_WD1); bf16* Win = (bf16*)(args.ws + WS_WIN); bf16* Wout = (bf16*)(args.ws + WS_WOUT);
    bf16* Wgu2 = (bf16*)(args.ws + WS_WGU2); bf16* Wd2 = (bf16*)(args.ws + WS_WD2);
    const int G = gridDim.x, bid = blockIdx.x, gw = bid * NWAVES + C.wave, NGW = G * NWAVES;
    const int lo = args.ph_lo, hi = args.ph_hi;
    cg::grid_group grid = cg::this_grid();
    float* PART = (float*)(args.ws + WS_PART);
    volatile LAS unsigned* MISC = (volatile LAS unsigned*)(lds + MISC_OFF);
    if (C.tid < 16) MISC[C.tid] = 0u;
    __syncthreads();
    XcdBarrier bar; bar.bar = (unsigned*)args.ws + CW_BAR; bar.x = 0; bar.st = nullptr;
    if (hi - lo > 1) bar = xcd_barrier_post((unsigned*)args.ws + CW_BAR, MISC + 8);
#define IN(k) (lo <= (k) && (k) < hi)
#define SEAM(k) do { if (IN(k) && IN((k) + 1)) { if ((k) == 0) grid.sync(); else xcd_barrier(bar); } } while (0)
#define YROW(m) ((m) < TP ? C.Y + (size_t)(m) * D : PART + (size_t)((m) - TP) * D)
#define NPARTS(m) ((m) < TP ? 1 : 4)
#define XROW(m) ((m) < TP ? C.in[0] + (size_t)(m) * D : C.in[1] + (size_t)((m) - TP) * D)

    if (IN(0)) {
        LAS float* scr = (LAS float*)(lds + C.wave * 16640);
        constexpr int I_GU = 16 * 88, I_DN = 44 * 16, I_IN = 16 * 44, I_OUT = 16 * 16, NIT = 2 * I_GU + 2 * I_DN + I_IN + I_OUT;
        for (int it = gw; it < NIT; it += NGW) {
            int r = it;
            if (r < I_GU) { transpose_item(C.in[12], D, 2 * FF, Wgu1, FF, 2, scr, r, C.lane); continue; } r -= I_GU;
            if (r < I_GU) { transpose_item(C.in[14], D, 2 * FF, Wgu2, FF, 2, scr, r, C.lane); continue; } r -= I_GU;
            if (r < I_DN) { transpose_item(C.in[13], FF, D, Wd1, D, 1, scr, r, C.lane); continue; } r -= I_DN;
            if (r < I_DN) { transpose_item(C.in[15], FF, D, Wd2, D, 1, scr, r, C.lane); continue; } r -= I_DN;
            if (r < I_IN) { transpose_item(C.in[5], D, ZP, Win, ZP, 1, scr, r, C.lane); continue; } r -= I_IN;
            transpose_item(C.in[11], D, D, Wout, D, 1, scr, r, C.lane);
        }
        for (int m = gw; m < T; m += NGW) rms_row_bf16(XROW(m), C.in[16], C.XN + (size_t)m * D, C.lane);
    }
    SEAM(0);
    if (IN(1)) { pg8::Gemm g{C.XN, Wgu1, T, 2 * FF, D}; pg8::StaticOrder S; S.init(T, 2 * FF, G, bid, D); EpiSwiGLU E{C.HID, FF};
        pg8::gemm_phase<EpiSwiGLU, pg8::StaticOrder, true, true>(lds, g, S, E); }
    SEAM(1);
    if (IN(2)) { pg8::Gemm g{C.HID, Wd1, T, D, FF}; pg8::SplitOrder S; S.init(G, bid, FF); EpiF32 E{C.Y, D, PART};
        pg8::gemm_phase<EpiF32, pg8::SplitOrder, true, true>(lds, g, S, E); }
    SEAM(2);
    if (IN(3)) { for (int m = gw; m < T; m += NGW) row_update(XROW(m), YROW(m), NPARTS(m), C.in[17], 0.5f, C.out + (size_t)m * D, C.in[18], C.XN + (size_t)m * D, C.lane); }
    SEAM(3);
    if (IN(4)) { pg8::Gemm g{C.XN, Win, T, ZP, D}; pg8::StaticOrder S; S.init(T, ZP, G, bid, D); pg8::EpiBf16<0> E{C.HID, ZP, C.in[6], 0, 0, 1.f};
        pg8::gemm_phase<pg8::EpiBf16<0>, pg8::StaticOrder, true, true>(lds, g, S, E); }
    SEAM(4);
    if (IN(5)) {
        for (int it = bid; it < 2048; it += G) {
            if (it < 1024) hgrn_local_item(C, lds, it);
            else if (it < 1280) attn_prompt_item(C, lds, it - 1024);
            else if (it < 1792) hgrn_sample_item(C, lds, it - 1280);
            else attn_sample_item(C, lds, it - 1792);
        }
    }
    SEAM(5);
    if (IN(6)) {
        for (int idx = bid * NTHR + C.tid; idx < 16 * 8192; idx += G * NTHR) {
            const int bh = idx >> 13, e2 = idx & 8191, v = e2 >> 6, k2 = (e2 & 63) * 2;
            f32x2 S = {0.f, 0.f};
            float* p = C.SLOC + (size_t)bh * 64 * 16384 + v * 128 + k2; const float* dp = C.DEC + (size_t)bh * 64 * 128 + k2;
#pragma unroll 8
            for (int c = 0; c < 64; ++c) { const f32x2 tmp = *(const f32x2*)(p + (size_t)c * 16384); const f32x2 d = *(const f32x2*)(dp + c * 128); *(f32x2*)(p + (size_t)c * 16384) = S; S = d * S + tmp; }
            float* so = C.out + OFF_SP + (size_t)bh * 16384 + (size_t)k2 * 128 + v; so[0] = S.x; so[128] = S.y;
        }
        for (int m = gw; m < T; m += NGW) {
            bf16* ar = C.MIX + (size_t)m * D + C.lane * 8; const v4u w = *(const v4u*)ar; float x[8]; float s = 0.f;
#pragma unroll
            for (int j = 0; j < 4; ++j) { x[2 * j] = bf2f(w[j] & 0xffffu); x[2 * j + 1] = bf2f(w[j] >> 16); s += x[2 * j] * x[2 * j] + x[2 * j + 1] * x[2 * j + 1]; }
            const float r = rsqrtf(wave_sum(s) * (1.f / 512.f) + EPS); const float* gp = C.in[8] + C.lane * 8; const f32x4 g0 = *(const f32x4*)gp, g1 = *(const f32x4*)(gp + 4);
            v4u o; o.x = cvtpk(x[0] * r * g0.x, x[1] * r * g0.y); o.y = cvtpk(x[2] * r * g0.z, x[3] * r * g0.w); o.z = cvtpk(x[4] * r * g1.x, x[5] * r * g1.y); o.w = cvtpk(x[6] * r * g1.z, x[7] * r * g1.w);
            *(v4u*)ar = o;
        }
    }
    SEAM(6);
    if (IN(7)) { for (int it = bid; it < 1024; it += G) hgrn_out_item(C, lds, it); }
    SEAM(7);
    if (IN(8)) { pg8::Gemm g{C.MIX, Wout, T, D, D}; pg8::SplitOrder S; S.init(G, bid, D); EpiF32 E{C.Y, D, PART};
        pg8::gemm_phase<EpiF32, pg8::SplitOrder, true, true>(lds, g, S, E); }
    SEAM(8);
    if (IN(9)) { for (int m = gw; m < T; m += NGW) row_update(C.out + (size_t)m * D, YROW(m), NPARTS(m), C.in[19], 1.0f, C.out + (size_t)m * D, C.in[20], C.XN + (size_t)m * D, C.lane); }
    SEAM(9);
    if (IN(10)) { pg8::Gemm g{C.XN, Wgu2, T, 2 * FF, D}; pg8::StaticOrder S; S.init(T, 2 * FF, G, bid, D); EpiSwiGLU E{C.HID, FF};
        pg8::gemm_phase<EpiSwiGLU, pg8::StaticOrder, true, true>(lds, g, S, E); }
    SEAM(10);
    if (IN(11)) { pg8::Gemm g{C.HID, Wd2, T, D, FF}; pg8::SplitOrder S; S.init(G, bid, FF); EpiF32 E{C.Y, D, PART};
        pg8::gemm_phase<EpiF32, pg8::SplitOrder, true, true>(lds, g, S, E); }
    SEAM(11);
    if (IN(12)) { for (int m = gw; m < T; m += NGW) row_update(C.out + (size_t)m * D, YROW(m), NPARTS(m), C.in[21], 0.5f, C.out + (size_t)m * D, nullptr, nullptr, C.lane); }
#undef IN
#undef SEAM
#undef XROW
#undef YROW
#undef NPARTS
}

extern "C" void kernel_launch(void* const* d_in, const int* in_sizes, int n_in, void* d_out, int out_size, void* d_ws, size_t ws_size, hipStream_t stream) {
    static int grid = 0;
    if (grid == 0) {
        if (n_in != 22 || ws_size < WS_END) { fprintf(stderr, "kernel_launch: unexpected inputs (n_in %d, ws %zu)\n", n_in, ws_size); grid = -1; return; }
        int dev = 0, cus = 0, per_cu = 0;
        (void)hipGetDevice(&dev); (void)hipDeviceGetAttribute(&cus, hipDeviceAttributeMultiprocessorCount, dev);
        if (hipFuncSetAttribute((const void*)fwd, hipFuncAttributeMaxDynamicSharedMemorySize, LDS_BYTES) != hipSuccess) { fprintf(stderr, "kernel_launch: hipFuncSetAttribute failed\n"); grid = -1; return; }
        if (hipOccupancyMaxActiveBlocksPerMultiprocessor(&per_cu, (const void*)fwd, NTHR, LDS_BYTES) != hipSuccess || per_cu < 1) per_cu = 1;
        (void)hipGetLastError();
        grid = cus * per_cu;
    }
    if (grid < 0) return;
    if (hipMemsetAsync(d_ws, 0, CTL_ZERO_BYTES, stream) != hipSuccess) { fprintf(stderr, "kernel_launch: memset failed\n"); return; }
    Args a{};
    for (int i = 0; i < 22; ++i) a.in[i] = (const float*)d_in[i];
    a.out = (float*)d_out; a.ws = (unsigned char*)d_ws;
#if MK_N_LAUNCHES == 1
    a.ph_lo = 0; a.ph_hi = NPH;
    void* kargs[] = {&a};
    hipError_t e = hipLaunchCooperativeKernel((const void*)fwd, dim3(grid), dim3(NTHR), kargs, LDS_BYTES, stream);
    if (e != hipSuccess) fprintf(stderr, "cooperative launch failed: %s (grid %d)\n", hipGetErrorString(e), grid);
#else
    for (int p = 0; p < NPH; ++p) { a.ph_lo = p; a.ph_hi = p + 1; hipLaunchKernelGGL(fwd, dim3(grid), dim3(NTHR), LDS_BYTES, stream, a); }
#endif
}
```

```cpp
#include <hip/hip_runtime.h>
#include <cstdio>
#include <cstdint>
namespace pg8 {
#define PG8_LAS __attribute__((address_space(3)))
typedef unsigned short bf16_t;
typedef short bf16x8 __attribute__((ext_vector_type(8)));
typedef float f32x4 __attribute__((ext_vector_type(4)));
typedef unsigned u32x4 __attribute__((ext_vector_type(4)));
constexpr int BM = 256, BK = 64, HALF = 128, HTB = HALF * BK * 2  , STAGE_BYTES = 8 * HTB, NXCD = 8, WGM = 8;

__host__ __device__ __forceinline__ int lds_byte(int r, int c) { const int st = (r >> 4) * 2 + (c >> 5), rr = r & 15, cc = c & 31, ob = rr * 64 + cc * 2; return st * 1024 + (ob ^ (((ob >> 9) & 1) << 5)); }
__host__ __device__ __forceinline__ void stage_rc(int b, int& R, int& C) { const int st = b / 1024, sb = b % 1024, swz = sb ^ (((sb >> 9) & 1) << 5); R = (st >> 1) * 16 + swz / 64; C = (st & 1) * 32 + (swz % 64) / 2; }
__host__ __device__ __forceinline__ int perm32(int rho) { const int n = rho >> 4, i = rho & 15; return 8 * (i >> 2) + 4 * n + (i & 3); }

struct Unit { int pm, pn, k0, nk, part; };
struct Gemm { const bf16_t* A; const bf16_t* Bt; int M, N, K; };

struct StaticOrder {
    int nM, nN, nwg, G, c, nkf;
    __host__ __device__ void init(int M, int N, int G_, int c_, int K) { nM = M / BM; nN = N / BM; nwg = nM * nN; G = G_; c = c_; nkf = K / BK; }
    __host__ __device__ bool next(int i, Unit& u) const {
        const long L = (long)i * G + c; if (L >= nwg) return false;
        int wgid = (int)L; { const int q = nwg / NXCD, r = nwg % NXCD, xcd = wgid % NXCD, off = wgid / NXCD; wgid = (xcd < r ? xcd * (q + 1) : r * (q + 1) + (xcd - r) * q) + off; }
        const int nig = WGM * nN, gid = wgid / nig, fm = gid * WGM, gsz = (nM - fm) < WGM ? (nM - fm) : WGM;
        u.pm = fm + ((wgid % nig) % gsz); u.pn = (wgid % nig) / gsz; u.k0 = 0; u.nk = nkf; u.part = -1; return true;
    }
    __device__ __forceinline__ void a_ready(const Unit&) const {}
    __device__ __forceinline__ void done(const Unit&) const {}
};

__device__ __forceinline__ unsigned cvt_pk_bf16(float lo, float hi) { unsigned r; asm volatile("v_cvt_pk_bf16_f32 %0, %1, %2" : "=v"(r) : "v"(lo), "v"(hi)); return r; }
typedef float f32x2 __attribute__((ext_vector_type(2)));
__device__ __forceinline__ f32x2 gelu_pk(f32x2 v) {
    const f32x2 av = __builtin_elementwise_abs(v), d = av * 0.2316418882f + 1.0f;
    f32x2 t; t.x = __builtin_amdgcn_rcpf(d.x); t.y = __builtin_amdgcn_rcpf(d.y);
    f32x2 q = t * 0.5307027145f + (-0.7265760135f); q = q * t + 0.7107068705f; q = q * t + (-0.142248368f); q = q * t + 0.127414796f; q = q * t;
    const f32x2 s = (v * v) * (-0.72134752044f);
    f32x2 e; e.x = __builtin_amdgcn_exp2f(s.x); e.y = __builtin_amdgcn_exp2f(s.y);
    const f32x2 m = v * (q * e), r = v - m;
    f32x2 o; o.x = v.x < 0.f ? m.x : r.x; o.y = v.y < 0.f ? m.y : r.y; return o;
}

template <int ACT  > struct EpiBf16 {
    static constexpr bool PERM = true, AFTER_DRAIN = false; static_assert(ACT == 0 || ACT == 1, "EpiBf16: ACT is 0 (none) or 1 (gelu_pk)");
    bf16_t* O; int ldc; const float* bias; int split_cols; size_t split_stride; float scale0;
    __device__ __forceinline__ void operator()(const f32x4 (&acc)[2][2][4][2], const Unit& u, int wr, int wc, int fr, int fq) const {
        const int row0 = u.pm * BM + wr * 64 + fr; int colt = u.pn * BM; bf16_t* base = O;
        float sc = 1.f; if (split_cols) { const int t = colt / split_cols; base += (size_t)t * split_stride; colt -= t * split_cols; if (t == 0) sc = scale0; }
        const int col0 = colt + wc * 32 + 8 * fq, bcol0 = u.pn * BM + wc * 32 + 8 * fq;
        f32x4 bv[2][2];
#pragma unroll
        for (int bj = 0; bj < 2; ++bj)
#pragma unroll
            for (int n = 0; n < 2; ++n) bv[bj][n] = bias ? *(const f32x4*)(bias + bcol0 + bj * HALF + 4 * n) : (f32x4){0.f, 0.f, 0.f, 0.f};
#pragma unroll
        for (int ai = 0; ai < 2; ++ai)
#pragma unroll
            for (int m = 0; m < 4; ++m) { bf16_t* rowp = base + (size_t)(row0 + ai * HALF + m * 16) * ldc + col0;
#pragma unroll
                for (int bj = 0; bj < 2; ++bj) { f32x4 v0 = acc[ai][bj][m][0] + bv[bj][0], v1 = acc[ai][bj][m][1] + bv[bj][1];
                    if (ACT == 1) { f32x2 a = gelu_pk((f32x2){v0[0], v0[1]}), b = gelu_pk((f32x2){v0[2], v0[3]}), c = gelu_pk((f32x2){v1[0], v1[1]}), d = gelu_pk((f32x2){v1[2], v1[3]});
                        v0 = (f32x4){a.x, a.y, b.x, b.y}; v1 = (f32x4){c.x, c.y, d.x, d.y}; }
                    v0 = v0 * sc; v1 = v1 * sc; u32x4 w; w.x = cvt_pk_bf16(v0[0], v0[1]); w.y = cvt_pk_bf16(v0[2], v0[3]); w.z = cvt_pk_bf16(v1[0], v1[1]); w.w = cvt_pk_bf16(v1[2], v1[3]);
                    *(u32x4*)(rowp + bj * HALF) = w; } }
    }
};
template <class Epi, class Sched, bool ALIGN_EPI = false, bool SP2 = false>
__device__ __forceinline__ void gemm_phase(PG8_LAS unsigned char* lds, const Gemm g, const Sched& S, const Epi& E) {
    const int tid = threadIdx.x, wid = __builtin_amdgcn_readfirstlane(tid >> 6), lane = tid & 63, wr = wid >> 2, wc = wid & 3, fr = lane & 15, fq = lane >> 4;
    const int K = g.K;
    unsigned voffA[2], voffB[2];
#pragma unroll
    for (int i = 0; i < 2; ++i) { int R, C; stage_rc(tid * 16 + i * 8192, R, C); const int Rb = Epi::PERM ? ((R & ~31) + perm32(R & 31)) : R;
        voffA[i] = (unsigned)(R * K + C) * 2u; voffB[i] = (unsigned)(Rb * K + C) * 2u; }
    const size_t kstep = (size_t)(BK * 2);
    const size_t hstep = (size_t)HALF * K * 2;
    const size_t tstep = 2 * hstep;
    const unsigned ldsw = (unsigned)wid * 1024u;
    const int aoff = lds_byte(wr * 64 + fr, fq * 8), boff = lds_byte(wc * 32 + fr, fq * 8);
#define PG8_SA(b, h) (((b) * 2 + (h)) * HTB)
#define PG8_SB(b, h) ((4 + (b) * 2 + (h)) * HTB)
#define PG8_STAGE(bufoff, gbase, voff) do { _Pragma("unroll") for (int _i = 0; _i < 2; ++_i) \
        __builtin_amdgcn_global_load_lds((const unsigned*)((const char*)(gbase) + (voff)[_i]), (PG8_LAS unsigned*)(lds + (bufoff) + ldsw + _i * 8192), 16, 0, 0); } while (0)
#define PG8_LDA(dst, b, h) do { _Pragma("unroll") for (int m = 0; m < 4; ++m) _Pragma("unroll") for (int k = 0; k < 2; ++k) dst[m][k] = *(const PG8_LAS bf16x8*)(lds + PG8_SA(b, h) + aoff + m * 2048 + k * 1024); } while (0)
#define PG8_LDB(dst, b, h) do { _Pragma("unroll") for (int n = 0; n < 2; ++n) _Pragma("unroll") for (int k = 0; k < 2; ++k) dst[n][k] = *(const PG8_LAS bf16x8*)(lds + PG8_SB(b, h) + boff + n * 2048 + k * 1024); } while (0)
#define PG8_MMA(ai, bj, At, Bt) do { __builtin_amdgcn_s_setprio(1); _Pragma("unroll") for (int m = 0; m < 4; ++m) _Pragma("unroll") for (int n = 0; n < 2; ++n) _Pragma("unroll") for (int k = 0; k < 2; ++k) \
        acc[ai][bj][m][n] = __builtin_amdgcn_mfma_f32_16x16x32_bf16(Bt[n][k], At[m][k], acc[ai][bj][m][n], 0, 0, 0); __builtin_amdgcn_s_setprio(0); } while (0)
#define PG8_WAIT_V(n) asm volatile("s_waitcnt vmcnt(" #n ")" ::: "memory")
#define PG8_WAIT_L(n) asm volatile("s_waitcnt lgkmcnt(" #n ")" ::: "memory")
#define PG8_BAR __builtin_amdgcn_s_barrier()
#define PG8_SCHED __builtin_amdgcn_sched_barrier(0)
    Unit cur, nxt; int ui = 0;
    if (!S.next(0, cur)) return;
    f32x4 acc[2][2][4][2];
#pragma unroll
    for (int a = 0; a < 2; ++a)
#pragma unroll
        for (int b = 0; b < 2; ++b)
#pragma unroll
            for (int m = 0; m < 4; ++m)
#pragma unroll
                for (int n = 0; n < 2; ++n) acc[a][b][m][n] = (f32x4){0.f, 0.f, 0.f, 0.f};
    bf16x8 At[4][2], B0[2][2], B1[2][2];
    const char* cA = (const char*)g.A + (size_t)cur.pm * tstep + (size_t)cur.k0 * kstep; const char* cB = (const char*)g.Bt + (size_t)cur.pn * tstep + (size_t)cur.k0 * kstep;
    S.a_ready(cur);
    if constexpr (SP2) {
        PG8_STAGE(PG8_SB(0, 0), cB, voffB); PG8_STAGE(PG8_SB(0, 1), cB + hstep, voffB); PG8_STAGE(PG8_SA(0, 0), cA, voffA); PG8_STAGE(PG8_SA(0, 1), cA + hstep, voffA);
        if (wr == 1) PG8_BAR;
        PG8_WAIT_V(2); PG8_BAR;
        PG8_STAGE(PG8_SB(1, 0), cB + kstep, voffB); PG8_STAGE(PG8_SA(1, 0), cA + kstep, voffA); PG8_STAGE(PG8_SB(1, 1), cB + hstep + kstep, voffB);
        PG8_WAIT_V(6); PG8_BAR;
    } else {
        PG8_STAGE(PG8_SB(0, 0), cB, voffB); PG8_STAGE(PG8_SA(0, 0), cA, voffA); PG8_STAGE(PG8_SB(0, 1), cB + hstep, voffB); PG8_STAGE(PG8_SA(0, 1), cA + hstep, voffA);
        if (wr == 1) PG8_BAR;
        PG8_WAIT_V(4); PG8_BAR;
        PG8_STAGE(PG8_SB(1, 0), cB + kstep, voffB); PG8_STAGE(PG8_SA(1, 0), cA + kstep, voffA); PG8_STAGE(PG8_SB(1, 1), cB + hstep + kstep, voffB);
        PG8_WAIT_V(6); PG8_BAR;
    }
    for (;;) {
        const bool has_next = S.next(ui + 1, nxt);
        const char* nA = has_next ? (const char*)g.A + (size_t)nxt.pm * tstep + (size_t)nxt.k0 * kstep : cA; const char* nB = has_next ? (const char*)g.Bt + (size_t)nxt.pn * tstep + (size_t)nxt.k0 * kstep : cB;
        const int nt = cur.nk;
        for (int t = 0; t < nt; t += 2) {
            const bool last = (t == nt - 2);
            const char* a1 = cA + (size_t)(t + 1) * kstep;
            const char* a2 = last ? nA : cA + (size_t)(t + 2) * kstep; const char* b2 = last ? nB : cB + (size_t)(t + 2) * kstep;
            const char* a3 = a2 + kstep; const char* b3 = b2 + kstep;
            if (last && has_next) S.a_ready(nxt);
            if constexpr (SP2) {
            PG8_LDB(B0, 0, 0); PG8_LDB(B1, 0, 1); PG8_SCHED; PG8_LDA(At, 0, 0); PG8_STAGE(PG8_SA(1, 1), a1 + hstep, voffA);
            PG8_WAIT_V(8); PG8_WAIT_L(0); PG8_BAR; PG8_MMA(0, 0, At, B0); PG8_MMA(0, 1, At, B1); PG8_BAR; PG8_SCHED;
            PG8_LDA(At, 0, 1); PG8_STAGE(PG8_SB(0, 0), b2, voffB); PG8_STAGE(PG8_SB(0, 1), b2 + hstep, voffB); PG8_STAGE(PG8_SA(0, 0), a2, voffA);
            PG8_WAIT_V(8); PG8_WAIT_L(0); PG8_BAR; PG8_MMA(1, 0, At, B0); PG8_MMA(1, 1, At, B1); PG8_BAR; PG8_SCHED;
            PG8_LDB(B0, 1, 0); PG8_LDB(B1, 1, 1); PG8_SCHED; PG8_LDA(At, 1, 0); PG8_STAGE(PG8_SA(0, 1), a2 + hstep, voffA);
            PG8_WAIT_V(8); PG8_WAIT_L(0); PG8_BAR; PG8_MMA(0, 0, At, B0); PG8_MMA(0, 1, At, B1); PG8_BAR; PG8_SCHED;
            PG8_LDA(At, 1, 1); PG8_STAGE(PG8_SB(1, 0), b3, voffB); PG8_STAGE(PG8_SB(1, 1), b3 + hstep, voffB); PG8_STAGE(PG8_SA(1, 0), a3, voffA);
            PG8_WAIT_V(8); PG8_WAIT_L(0); PG8_BAR; PG8_MMA(1, 0, At, B0); PG8_MMA(1, 1, At, B1); PG8_BAR; PG8_SCHED;
            } else {
            PG8_LDB(B0, 0, 0); PG8_SCHED; PG8_LDA(At, 0, 0); PG8_STAGE(PG8_SA(1, 1), a1 + hstep, voffA);
            PG8_WAIT_L(8); PG8_BAR; PG8_WAIT_L(0); PG8_MMA(0, 0, At, B0); PG8_BAR; PG8_SCHED;
            PG8_LDB(B1, 0, 1); PG8_STAGE(PG8_SB(0, 0), b2, voffB);
            PG8_BAR; PG8_WAIT_L(0); PG8_MMA(0, 1, At, B1); PG8_BAR;
            PG8_LDA(At, 0, 1); PG8_STAGE(PG8_SA(0, 0), a2, voffA);
            PG8_BAR; PG8_WAIT_L(0); PG8_MMA(1, 0, At, B0); PG8_BAR; PG8_SCHED;
            PG8_STAGE(PG8_SB(0, 1), b2 + hstep, voffB);
            PG8_WAIT_V(6); PG8_BAR; PG8_MMA(1, 1, At, B1); PG8_BAR;
            PG8_LDB(B0, 1, 0); PG8_SCHED; PG8_LDA(At, 1, 0); PG8_STAGE(PG8_SA(0, 1), a2 + hstep, voffA);
            PG8_WAIT_L(8); PG8_BAR; PG8_WAIT_L(0); PG8_MMA(0, 0, At, B0); PG8_BAR; PG8_SCHED;
            PG8_LDB(B1, 1, 1); PG8_STAGE(PG8_SB(1, 0), b3, voffB);
            PG8_BAR; PG8_WAIT_L(0); PG8_MMA(0, 1, At, B1); PG8_BAR;
            PG8_LDA(At, 1, 1); PG8_STAGE(PG8_SA(1, 0), a3, voffA);
            PG8_BAR; PG8_WAIT_L(0); PG8_MMA(1, 0, At, B0); PG8_BAR; PG8_SCHED;
            PG8_STAGE(PG8_SB(1, 1), b3 + hstep, voffB);
            PG8_WAIT_V(6); PG8_BAR; PG8_MMA(1, 1, At, B1); PG8_BAR;
            }
        }
        if constexpr (ALIGN_EPI) { if (wr == 0) PG8_BAR; }
        if constexpr (!Epi::AFTER_DRAIN) { E(acc, cur, wr, wc, fr, fq); S.done(cur); }
        if (!has_next) break;
#pragma unroll
        for (int a = 0; a < 2; ++a)
#pragma unroll
            for (int b = 0; b < 2; ++b)
#pragma unroll
                for (int m = 0; m < 4; ++m)
#pragma unroll
                    for (int n = 0; n < 2; ++n) acc[a][b][m][n] = (f32x4){0.f, 0.f, 0.f, 0.f};
        cur = nxt; cA = nA; cB = nB; ++ui;
        if constexpr (ALIGN_EPI) { if (wr == 1) PG8_BAR; }
    }
    PG8_WAIT_V(0);
    if constexpr (!ALIGN_EPI) { if (wr == 0) PG8_BAR; }
    PG8_BAR;
    if constexpr (Epi::AFTER_DRAIN) { E.fused(acc, cur, wr, wc, fr, fq, lds, wid, lane); S.done(cur); }
#undef PG8_SA
#undef PG8_SB
#undef PG8_STAGE
#undef PG8_LDA
#undef PG8_LDB
#undef PG8_MMA
#undef PG8_WAIT_V
#undef PG8_WAIT_L
#undef PG8_BAR
#undef PG8_SCHED
}

struct SplitOrder {
    int G, c, nkf;
    __host__ __device__ void init(int G_, int c_, int K) { G = G_; c = c_; nkf = K / BK; }
    __host__ __device__ bool next(int i, Unit& u) const {
        const int L = i * G + c;
        if (L < 256) { const int xcd = L % NXCD, off = L / NXCD, w = xcd * 32 + off; u.pm = (w / 32) * WGM + (w % 32) % WGM; u.pn = (w % 32) / WGM; u.k0 = 0; u.nk = nkf; u.part = -1; return true; }
        const int s = L - 256; if (s >= 64) return false;
        const int tile = s >> 2, sp = s & 3, pairs = nkf / 2, base = pairs / 4, rem = pairs % 4;
        u.pm = 64 + (tile >> 2); u.pn = tile & 3; u.k0 = 2 * (sp * base + (sp < rem ? sp : rem)); u.nk = 2 * (base + (sp < rem ? 1 : 0)); u.part = sp; return true;
    }
    __device__ __forceinline__ void a_ready(const Unit&) const {}
    __device__ __forceinline__ void done(const Unit&) const {}
};
}

#include <hip/hip_cooperative_groups.h>
namespace cg = cooperative_groups;

#define GAS __attribute__((address_space(1)))
#define LAS __attribute__((address_space(3)))
typedef unsigned short bf16;
typedef unsigned v4u __attribute__((ext_vector_type(4)));
typedef unsigned v2u __attribute__((ext_vector_type(2)));
typedef float f32x4 __attribute__((ext_vector_type(4)));
typedef float f32x2 __attribute__((ext_vector_type(2)));
typedef float f32x16 __attribute__((ext_vector_type(16)));
typedef short bf16x8 __attribute__((ext_vector_type(8)));
typedef short s16x4 __attribute__((ext_vector_type(4)));
typedef __bf16 bf16x2_t __attribute__((ext_vector_type(2)));

#ifndef MK_N_LAUNCHES
#define MK_N_LAUNCHES 1
#endif

constexpr int NWAVES = 8, NTHR = 512;
constexpr int D = 1024, TP = 16384, TS = 1024, T = TP + TS, SEQ = 4096, NB = 4, DB = 128, DL = 8;
constexpr int FF = 2816, ZP = 2816;
constexpr int ZK = 512, ZV = 640, ZHQ = 768, ZHF = 1280, ZHI = 1792, ZHG = 2304;
constexpr float EPS = 1e-6f;
constexpr int NPH = 13;

constexpr size_t MiB = 1u << 20;
constexpr size_t WS_WGU1 = 1 * MiB, WS_WD1 = 12 * MiB, WS_WIN = 17 * MiB + 512 * 1024, WS_WOUT = 23 * MiB, WS_WGU2 = 25 * MiB, WS_WD2 = 36 * MiB;
constexpr size_t WS_DEC = 42 * MiB, WS_XN = 43 * MiB, WS_HID = 77 * MiB, WS_Y = 171 * MiB, WS_PART = 239 * MiB, WS_END = 255 * MiB;
constexpr size_t CTL_ZERO_BYTES = 65536; constexpr int CW_BAR = 4096;
constexpr int MISC_OFF = 147456 - 64;
constexpr size_t OFF_KWP = (size_t)T * D, OFF_VWP = OFF_KWP + 65536, OFF_SP = OFF_VWP + 65536, OFF_KWS = OFF_SP + 262144, OFF_VWS = OFF_KWS + 2097152, OFF_SS = OFF_VWS + 2097152;
constexpr int LDS_BYTES = 147456;

#define MFMA32(a, b, c) __builtin_amdgcn_mfma_f32_32x32x16_bf16((a), (b), (c), 0, 0, 0)

__device__ __forceinline__ float bf2f(unsigned u) { return __uint_as_float(u << 16); }
__device__ __forceinline__ unsigned cvtpk(float lo, float hi) { f32x2 v = {lo, hi}; bf16x2_t b = __builtin_convertvector(v, bf16x2_t); return __builtin_bit_cast(unsigned, b); }
__device__ __forceinline__ float wave_sum(float v) {
#pragma unroll
    for (int o = 1; o < 64; o <<= 1) v += __shfl_xor(v, o);
    return v;
}
__device__ __forceinline__ float sigmoidf_(float x) { return __builtin_amdgcn_rcpf(1.f + __expf(-x)); }
__device__ __forceinline__ float siluf_(float x) { return x * sigmoidf_(x); }
__device__ __forceinline__ int crow(int reg, int h) { return (reg & 3) + 8 * (reg >> 2) + 4 * h; }

struct EpiSwiGLU {
    static constexpr bool PERM = true, AFTER_DRAIN = false;
    bf16* O; int ldo;
    __device__ __forceinline__ void operator()(const pg8::f32x4 (&acc)[2][2][4][2], const pg8::Unit& u, int wr, int wc, int fr, int fq) const {
        const int row0 = u.pm * 256 + wr * 64 + fr, j0 = u.pn * 128 + wc * 16 + 4 * fq;
#pragma unroll
        for (int ai = 0; ai < 2; ++ai)
#pragma unroll
            for (int m = 0; m < 4; ++m) { bf16* rowp = O + (size_t)(row0 + ai * 128 + m * 16) * ldo + j0;
#pragma unroll
                for (int bj = 0; bj < 2; ++bj) { const pg8::f32x4 v0 = acc[ai][bj][m][0], v1 = acc[ai][bj][m][1];
                    const float h0 = siluf_(v0[0]) * v0[1], h1 = siluf_(v0[2]) * v0[3], h2 = siluf_(v1[0]) * v1[1], h3 = siluf_(v1[2]) * v1[3];
                    v2u w; w.x = cvtpk(h0, h1); w.y = cvtpk(h2, h3);
                    *(v2u*)(rowp + bj * 64) = w; } }
    }
};
struct EpiF32 {
    static constexpr bool PERM = false, AFTER_DRAIN = false;
    float* O; int ldc; float* P;
    __device__ __forceinline__ void operator()(const pg8::f32x4 (&acc)[2][2][4][2], const pg8::Unit& u, int wr, int wc, int fr, int fq) const {
        int row0 = u.pm * 256 + wr * 64 + fr; const int col0 = u.pn * 256 + wc * 32 + 4 * fq; float* base = O;
        if (u.part >= 0) { row0 -= 16384; base = P + (size_t)u.part * (1024 * 1024); }
#pragma unroll
        for (int ai = 0; ai < 2; ++ai)
#pragma unroll
            for (int m = 0; m < 4; ++m) { float* rowp = base + (size_t)(row0 + ai * 128 + m * 16) * ldc + col0;
#pragma unroll
                for (int bj = 0; bj < 2; ++bj)
#pragma unroll
                    for (int n = 0; n < 2; ++n) *(pg8::f32x4*)(rowp + bj * 128 + n * 16) = acc[ai][bj][m][n]; }
    }
};

__device__ __forceinline__ void transpose_item(const float* W, int K, int N, bf16* WT, int split, int mul, LAS float* scr, int item, int lane) {
    const int nblk = N / 64, kb = item / nblk, nb = item % nblk, k0 = 64 * kb, n0 = 64 * nb, kr = lane >> 4, n4 = (lane & 15) * 4;
    f32x4 v[16];
#pragma unroll
    for (int i = 0; i < 16; ++i) v[i] = *(const f32x4*)(W + (size_t)(k0 + 4 * i + kr) * N + n0 + n4);
#pragma unroll
    for (int i = 0; i < 16; ++i) { LAS float* s = scr + (4 * i + kr) * 65 + n4; s[0] = v[i].x; s[1] = v[i].y; s[2] = v[i].z; s[3] = v[i].w; }
    asm volatile("s_waitcnt lgkmcnt(0)" ::: "memory");
    const int c = lane & 7, part = n0 / split, nbase = n0 - part * split;
#pragma unroll
    for (int j = 0; j < 8; ++j) { const int n = (lane >> 3) + 8 * j; const LAS float* s = scr + (8 * c) * 65 + n;
        v4u o; o.x = cvtpk(s[0 * 65], s[1 * 65]); o.y = cvtpk(s[2 * 65], s[3 * 65]); o.z = cvtpk(s[4 * 65], s[5 * 65]); o.w = cvtpk(s[6 * 65], s[7 * 65]);
        *(v4u*)(WT + (size_t)((nbase + n) * mul + part) * K + k0 + 8 * c) = o; }
    asm volatile("s_waitcnt lgkmcnt(0)" ::: "memory");
}
__device__ __forceinline__ void rms_row_bf16(const float* xrow, const float* g, bf16* orow, int lane) {
    f32x4 v[4]; float s = 0.f;
#pragma unroll
    for (int j = 0; j < 4; ++j) { v[j] = ((const f32x4*)xrow)[lane + 64 * j]; s += (v[j].x * v[j].x + v[j].y * v[j].y) + (v[j].z * v[j].z + v[j].w * v[j].w); }
    const float r = rsqrtf(wave_sum(s) * (1.f / D) + EPS);
#pragma unroll
    for (int j = 0; j < 4; ++j) { const f32x4 gg = ((const f32x4*)g)[lane + 64 * j]; const f32x4 o = v[j] * gg * r;
        v2u w; w.x = cvtpk(o.x, o.y); w.y = cvtpk(o.z, o.w); ((v2u*)orow)[lane + 64 * j] = w; }
}
__device__ __forceinline__ void row_update(const float* xin, const float* y, int nparts, const float* gpost, float coef, float* xout, const float* gnext, bf16* xn, int lane) {
    f32x4 yv[4], xv[4]; float s = 0.f;
#pragma unroll
    for (int j = 0; j < 4; ++j) { yv[j] = ((const f32x4*)y)[lane + 64 * j];
        if (nparts > 1) {
#pragma unroll
            for (int p = 1; p < 4; ++p) yv[j] += ((const f32x4*)(y + (size_t)p * (1024 * 1024)))[lane + 64 * j]; }
        s += (yv[j].x * yv[j].x + yv[j].y * yv[j].y) + (yv[j].z * yv[j].z + yv[j].w * yv[j].w); }
#pragma unroll
    for (int j = 0; j < 4; ++j) xv[j] = ((const f32x4*)xin)[lane + 64 * j];
    const float r = rsqrtf(wave_sum(s) * (1.f / D) + EPS) * coef;
    float s2 = 0.f;
#pragma unroll
    for (int j = 0; j < 4; ++j) { const f32x4 gg = ((const f32x4*)gpost)[lane + 64 * j]; xv[j] = xv[j] + yv[j] * gg * r;
        s2 += (xv[j].x * xv[j].x + xv[j].y * xv[j].y) + (xv[j].z * xv[j].z + xv[j].w * xv[j].w); ((f32x4*)xout)[lane + 64 * j] = xv[j]; }
    if (xn) {
        const float r2 = rsqrtf(wave_sum(s2) * (1.f / D) + EPS);
#pragma unroll
        for (int j = 0; j < 4; ++j) { const f32x4 gg = ((const f32x4*)gnext)[lane + 64 * j]; const f32x4 o = xv[j] * gg * r2;
            v2u w; w.x = cvtpk(o.x, o.y); w.y = cvtpk(o.z, o.w); ((v2u*)xn)[lane + 64 * j] = w; }
    }
}

constexpr int KSB = 144, VPB = 528;
__device__ __forceinline__ void attn_core(const LAS unsigned char* Ks, const LAS unsigned char* Vt, const bf16x8 (&qf)[4], bf16* optr, int kbase, int lo, int hi, float sink, int r, int h) {
    f32x16 st[5];
#pragma unroll
    for (int kt = 0; kt < 5; ++kt) {
#pragma unroll
        for (int i = 0; i < 16; ++i) st[kt][i] = 0.f;
#pragma unroll
        for (int s = 0; s < 4; ++s) { const bf16x8 kf = *(const LAS bf16x8*)(Ks + (kbase + 32 * kt + r) * KSB + (16 * s + 8 * h) * 2); st[kt] = MFMA32(kf, qf[s], st[kt]); }
    }
    float mx = sink;
#pragma unroll
    for (int kt = 0; kt < 5; ++kt)
#pragma unroll
        for (int i = 0; i < 16; ++i) { const int j = kbase + 32 * kt + crow(i, h); const float v = (j >= lo && j <= hi) ? st[kt][i] * 0.125f : -INFINITY; st[kt][i] = v; mx = fmaxf(mx, v); }
    mx = fmaxf(mx, __shfl_xor(mx, 32));
    float sum = 0.f;
#pragma unroll
    for (int kt = 0; kt < 5; ++kt)
#pragma unroll
        for (int i = 0; i < 16; ++i) { const float p = __expf(st[kt][i] - mx); st[kt][i] = p; sum += p; }
    sum += __shfl_xor(sum, 32);
    const float inv = 1.f / (sum + __expf(sink - mx));
    f32x16 o[2];
#pragma unroll
    for (int mt = 0; mt < 2; ++mt)
#pragma unroll
        for (int i = 0; i < 16; ++i) o[mt][i] = 0.f;
#pragma unroll
    for (int kt = 0; kt < 5; ++kt)
#pragma unroll
        for (int s2 = 0; s2 < 2; ++s2) {
            v4u pw; pw.x = cvtpk(st[kt][8 * s2 + 0], st[kt][8 * s2 + 1]); pw.y = cvtpk(st[kt][8 * s2 + 2], st[kt][8 * s2 + 3]); pw.z = cvtpk(st[kt][8 * s2 + 4], st[kt][8 * s2 + 5]); pw.w = cvtpk(st[kt][8 * s2 + 6], st[kt][8 * s2 + 7]);
            const bf16x8 pb = __builtin_bit_cast(bf16x8, pw);
#pragma unroll
            for (int mt = 0; mt < 2; ++mt) {
                const LAS unsigned char* vp = Vt + (32 * mt + r) * VPB + (kbase + 32 * kt + 16 * s2 + 4 * h) * 2;
                const s16x4 l4 = *(const LAS s16x4*)vp, h4 = *(const LAS s16x4*)(vp + 16);
                const bf16x8 va = __builtin_shufflevector(l4, h4, 0, 1, 2, 3, 4, 5, 6, 7);
                o[mt] = MFMA32(va, pb, o[mt]);
            }
        }
#pragma unroll
    for (int mt = 0; mt < 2; ++mt)
#pragma unroll
        for (int i4 = 0; i4 < 4; ++i4) { v2u w; w.x = cvtpk(o[mt][4 * i4] * inv, o[mt][4 * i4 + 1] * inv); w.y = cvtpk(o[mt][4 * i4 + 2] * inv, o[mt][4 * i4 + 3] * inv);
            *(v2u*)(optr + 32 * mt + 8 * i4 + 4 * h) = w; }
}

#define XB_TMO      128
#define XB_XCNT(j)  (256  + 64 * (j))
#define XB_XSUB(j)  (1280 + 64 * (j))
#define XB_XGEN(j)  (2304 + 64 * (j))
#define XB_TOP      3328
#define XB_TOPGEN   3392
#define XCD_BAR_WORDS 3456
#define XB_SPIN_CAP (1u << 18)

__device__ __forceinline__ unsigned xb_ld(unsigned* p)              { return __hip_atomic_load(p, __ATOMIC_RELAXED, __HIP_MEMORY_SCOPE_AGENT); }
__device__ __forceinline__ unsigned xb_add(unsigned* p, unsigned v) { return __hip_atomic_fetch_add(p, v, __ATOMIC_RELAXED, __HIP_MEMORY_SCOPE_AGENT); }
__device__ __forceinline__ unsigned xb_xcc_id() { return (unsigned)__builtin_amdgcn_s_getreg((3 << 11) | 20) & 0xFu; }
#define XB_SPIN(cond, bar) do { unsigned _sp = 0; while (cond) { __builtin_amdgcn_s_sleep(1); \
    if ((++_sp & 255u) == 0u) { if (xb_ld(&(bar)[XB_TMO])) break; if (_sp > XB_SPIN_CAP) { atomicAdd(&(bar)[XB_TMO], 1u); break; } } } } while (0)

struct XcdBarrier {
    unsigned* bar; unsigned x;
    volatile LAS unsigned* st;
};

__device__ __forceinline__ XcdBarrier xcd_barrier_post(unsigned* bar, volatile LAS unsigned* st) {
    XcdBarrier b; b.bar = bar; b.x = xb_xcc_id(); b.st = st;
    if (threadIdx.x == 0) (void)xb_add(&bar[XB_XCNT(b.x)], 1u);
    return b;
}
__device__ __forceinline__ void xcd_barrier_complete(unsigned* bar, unsigned x, unsigned& nloc, unsigned& nx) {
    const unsigned G = gridDim.x * gridDim.y * gridDim.z;
    unsigned sum, cnt, mine, sp = 0u;
    for (;;) {
        sum = 0u; cnt = 0u; mine = 0u;
#pragma unroll
        for (unsigned j = 0; j < 16; ++j) { const unsigned c = xb_ld(&bar[XB_XCNT(j)]); sum += c; cnt += (c > 0u) ? 1u : 0u; mine = (j == x) ? c : mine; }
        if (sum == G) break;
        __builtin_amdgcn_s_sleep(1);
        if ((++sp & 255u) == 0u) { if (xb_ld(&bar[XB_TMO])) break; if (sp > XB_SPIN_CAP) { atomicAdd(&bar[XB_TMO], 1u); break; } }
    }
    nloc = mine > 0u ? mine : 1u; nx = cnt > 0u ? cnt : 1u;
}

__device__ __forceinline__ void xcd_barrier(const XcdBarrier& b) {
    asm volatile("s_waitcnt vmcnt(0)" ::: "memory");
    __syncthreads();
    if (threadIdx.x == 0) {
        unsigned* bar = b.bar;
        __builtin_amdgcn_s_waitcnt(0);
        unsigned nloc = b.st[0], nx = b.st[1];
        if (nloc == 0u) { xcd_barrier_complete(bar, b.x, nloc, nx); b.st[0] = nloc; b.st[1] = nx; }
        const unsigned old = xb_add(&bar[XB_XSUB(b.x)], 1u);
        const unsigned gen = old / nloc;
        if (old + 1u == (gen + 1u) * nloc) {
            __builtin_amdgcn_fence(__ATOMIC_RELEASE, "agent");
            asm volatile("s_waitcnt vmcnt(0)" ::: "memory");
            const unsigned og = xb_add(&bar[XB_TOP], 1u);
            const unsigned tg = og / nx;
            if (og + 1u == (tg + 1u) * nx) xb_add(&bar[XB_TOPGEN], 1u);
            else XB_SPIN(xb_ld(&bar[XB_TOPGEN]) == tg, bar);
            __builtin_amdgcn_fence(__ATOMIC_ACQUIRE, "agent");
            xb_add(&bar[XB_XGEN(b.x)], 1u);
            asm volatile("s_waitcnt vmcnt(0)" ::: "memory");
        } else {
            XB_SPIN(xb_ld(&bar[XB_XGEN(b.x)]) == gen, bar);
            __builtin_amdgcn_fence(__ATOMIC_ACQUIRE, "agent");
            asm volatile("s_waitcnt vmcnt(0)" ::: "memory");
        }
    }
    __syncthreads();
}

struct Ctx {
    const float* in[22]; float* out; unsigned char* ws;
    bf16 *XN, *HID, *MIX; float *Y, *SLOC, *DEC;
    int tid, lane, wave;
};

__device__ __forceinline__ void attn_prompt_item(const Ctx& C, LAS unsigned char* lds, int item) {
    const int kvh = item & 1, n = (item >> 1) & 31, b = item >> 6;
    LAS unsigned char* Ks = lds; LAS unsigned char* Vt = lds + 256 * KSB;
    const bf16* Z = C.HID;
    const int g = C.wave >> 1, qh = C.wave & 1, r = C.lane & 31, h = C.lane >> 5;
    {
        const int key = C.tid >> 1, dh = C.tid & 1, tok = (n - 1) * 128 + key;
        v4u kv[4], vv[4];
        if (tok >= 0) { const bf16* zr = Z + (size_t)(b * SEQ + tok) * ZP + kvh * 64 + dh * 32;
#pragma unroll
            for (int j = 0; j < 4; ++j) { kv[j] = *(const v4u*)(zr + ZK + 8 * j); vv[j] = *(const v4u*)(zr + ZV + 8 * j); }
        } else {
#pragma unroll
            for (int j = 0; j < 4; ++j) { kv[j] = (v4u){0u, 0u, 0u, 0u}; vv[j] = (v4u){0u, 0u, 0u, 0u}; }
        }
#pragma unroll
        for (int j = 0; j < 4; ++j) *(LAS v4u*)(Ks + key * KSB + dh * 64 + 16 * j) = kv[j];
#pragma unroll
        for (int j = 0; j < 4; ++j)
#pragma unroll
            for (int e = 0; e < 4; ++e) { const unsigned w = vv[j][e]; const int d = dh * 32 + 8 * j + 2 * e;
                *(LAS unsigned short*)(Vt + d * VPB + key * 2) = (unsigned short)(w & 0xffffu); *(LAS unsigned short*)(Vt + (d + 1) * VPB + key * 2) = (unsigned short)(w >> 16); }
        if (n == 31 && key >= 128) {
            float* ko = C.out + OFF_KWP + ((size_t)(b * 128 + key - 128) * 2 + kvh) * 64 + dh * 32; float* vo = C.out + OFF_VWP + ((size_t)(b * 128 + key - 128) * 2 + kvh) * 64 + dh * 32;
#pragma unroll
            for (int j = 0; j < 4; ++j) {
                *(f32x4*)(ko + 8 * j) = (f32x4){bf2f(kv[j][0] & 0xffffu), bf2f(kv[j][0] >> 16), bf2f(kv[j][1] & 0xffffu), bf2f(kv[j][1] >> 16)};
                *(f32x4*)(ko + 8 * j + 4) = (f32x4){bf2f(kv[j][2] & 0xffffu), bf2f(kv[j][2] >> 16), bf2f(kv[j][3] & 0xffffu), bf2f(kv[j][3] >> 16)};
                *(f32x4*)(vo + 8 * j) = (f32x4){bf2f(vv[j][0] & 0xffffu), bf2f(vv[j][0] >> 16), bf2f(vv[j][1] & 0xffffu), bf2f(vv[j][1] >> 16)};
                *(f32x4*)(vo + 8 * j + 4) = (f32x4){bf2f(vv[j][2] & 0xffffu), bf2f(vv[j][2] >> 16), bf2f(vv[j][3] & 0xffffu), bf2f(vv[j][3] >> 16)}; }
        }
    }
    __syncthreads();
    const float sink = C.in[7][kvh * 4 + g];
#pragma unroll 1
    for (int sb = 0; sb < 2; ++sb) {
        const int q0 = 64 * qh + 32 * sb, qi = q0 + r; const size_t row = (size_t)(b * SEQ + n * 128 + qi);
        const bf16* qp = Z + row * ZP + kvh * 256 + g * 64;
        bf16x8 qf[4];
#pragma unroll
        for (int s = 0; s < 4; ++s) qf[s] = *(const bf16x8*)(qp + 16 * s + 8 * h);
        attn_core(Ks, Vt, qf, C.MIX + row * D + kvh * 256 + g * 64, q0, (n == 0) ? 128 : qi, qi + 128, sink, r, h);
    }
    __syncthreads();
}
__device__ __forceinline__ void attn_sample_item(const Ctx& C, LAS unsigned char* lds, int item) {
    const int kvh = item & 1, b = item >> 1;
    LAS unsigned char* Ks = lds; LAS unsigned char* Vt = lds + 256 * KSB;
    const bf16* Z = C.HID; const float* ck = C.in[2]; const float* cv = C.in[3];
    const int d4 = (C.tid & 15) * 4, jb = C.tid >> 4;
    f32x4 kf[5], vf[5];
#pragma unroll
    for (int it = 0; it < 4; ++it) { const size_t o = ((size_t)(b * 128 + jb + 32 * it) * 2 + kvh) * 64 + d4; kf[it] = *(const f32x4*)(ck + o); vf[it] = *(const f32x4*)(cv + o); }
    kf[4] = (f32x4){0.f, 0.f, 0.f, 0.f}; vf[4] = kf[4];
    if (jb < 8) { const bf16* zr = Z + (size_t)(TP + b * DL + jb) * ZP + kvh * 64 + d4; const v2u kw = *(const v2u*)(zr + ZK), vw = *(const v2u*)(zr + ZV);
        kf[4] = (f32x4){bf2f(kw.x & 0xffffu), bf2f(kw.x >> 16), bf2f(kw.y & 0xffffu), bf2f(kw.y >> 16)}; vf[4] = (f32x4){bf2f(vw.x & 0xffffu), bf2f(vw.x >> 16), bf2f(vw.y & 0xffffu), bf2f(vw.y >> 16)}; }
    bf16x8 qf[4];
    {   const int r = C.lane & 31, h = C.lane >> 5, g = r >> 3, i = r & 7; const bf16* qp = Z + (size_t)(TP + b * DL + i) * ZP + kvh * 256 + g * 64;
#pragma unroll
        for (int s = 0; s < 4; ++s) qf[s] = *(const bf16x8*)(qp + 16 * s + 8 * h); }
#pragma unroll
    for (int it = 0; it < 5; ++it) {
        const int j = jb + 32 * it;
        if (j >= 8 && j < 136) { const size_t o = ((size_t)(b * 128 + j - 8) * 2 + kvh) * 64 + d4; *(f32x4*)(C.out + OFF_KWS + o) = kf[it]; *(f32x4*)(C.out + OFF_VWS + o) = vf[it]; }
        v2u kw; kw.x = cvtpk(kf[it].x, kf[it].y); kw.y = cvtpk(kf[it].z, kf[it].w); *(LAS v2u*)(Ks + j * KSB + d4 * 2) = kw;
        const unsigned v01 = cvtpk(vf[it].x, vf[it].y), v23 = cvtpk(vf[it].z, vf[it].w);
        *(LAS unsigned short*)(Vt + (d4 + 0) * VPB + j * 2) = (unsigned short)(v01 & 0xffffu); *(LAS unsigned short*)(Vt + (d4 + 1) * VPB + j * 2) = (unsigned short)(v01 >> 16);
        *(LAS unsigned short*)(Vt + (d4 + 2) * VPB + j * 2) = (unsigned short)(v23 & 0xffffu); *(LAS unsigned short*)(Vt + (d4 + 3) * VPB + j * 2) = (unsigned short)(v23 >> 16);
    }
    __syncthreads();
    if (C.wave == 0) {
        const int r = C.lane & 31, h = C.lane >> 5, g = r >> 3, i = r & 7; const size_t row = (size_t)(TP + b * DL + i);
        attn_core(Ks, Vt, qf, C.MIX + row * D + kvh * 256 + g * 64, 0, i, 128 + i, C.in[7][kvh * 4 + g], r, h);
    }
    __syncthreads();
}

constexpr int TPB = 144;
constexpr int KQB = 272;
__device__ __forceinline__ void hgrn_local_item(const Ctx& C, LAS unsigned char* lds, int item) {
    const int c = item & 63, h = (item >> 6) & 3, b = item >> 8;
    const bf16* Z = C.HID + (size_t)(b * SEQ + c * 64) * ZP;
    LAS unsigned char* KtT = lds; LAS unsigned char* VT = lds + 128 * TPB; LAS float* segs = (LAS float*)(lds + 2 * 128 * TPB);
    const int seg = C.tid >> 7, k = C.tid & 127;
    const float l0 = C.in[9][h * 128 + k], l1 = C.in[9][512 + h * 128 + k], lb = sigmoidf_(l0 - l1);
    float G[16], kk[16]; float cum = 0.f; unsigned vraw[16], fraw[16];
#pragma unroll
    for (int e = 0; e < 16; ++e) { const bf16* zr = Z + (size_t)(seg * 16 + e) * ZP + h * 128 + k; fraw[e] = zr[ZHF]; vraw[e] = zr[ZHI]; }
    __builtin_amdgcn_sched_barrier(0);
#pragma unroll
    for (int e = 0; e < 16; ++e) { const float hf = bf2f(fraw[e]);
        const float sg = sigmoidf_(hf), f = lb + (1.f - lb) * sg; cum += __logf(f); G[e] = cum; kk[e] = 1.f - f; }
    segs[seg * 128 + k] = cum;
    __syncthreads();
    float off = 0.f, tot = 0.f;
#pragma unroll
    for (int s = 0; s < 4; ++s) { const float v = segs[s * 128 + k]; tot += v; if (s < seg) off += v; }
    {
        unsigned kw[8], vw[8];
#pragma unroll
        for (int e = 0; e < 8; ++e) { kw[e] = cvtpk(kk[2 * e] * __expf(tot - off - G[2 * e]), kk[2 * e + 1] * __expf(tot - off - G[2 * e + 1])); vw[e] = vraw[2 * e] | (vraw[2 * e + 1] << 16); }
        *(LAS v4u*)(KtT + k * TPB + seg * 32) = (v4u){kw[0], kw[1], kw[2], kw[3]}; *(LAS v4u*)(KtT + k * TPB + seg * 32 + 16) = (v4u){kw[4], kw[5], kw[6], kw[7]};
        *(LAS v4u*)(VT + k * TPB + seg * 32) = (v4u){vw[0], vw[1], vw[2], vw[3]}; *(LAS v4u*)(VT + k * TPB + seg * 32 + 16) = (v4u){vw[4], vw[5], vw[6], vw[7]};
    }
    if (seg == 0) C.DEC[(size_t)item * 128 + k] = __expf(tot);
    __syncthreads();
    const int r = C.lane & 31, h2 = C.lane >> 5, vt = C.wave >> 1;
    float* So = C.SLOC + (size_t)item * 16384;
#pragma unroll
    for (int kk2 = 0; kk2 < 2; ++kk2) {
        const int kt = (C.wave & 1) * 2 + kk2;
        f32x16 acc;
#pragma unroll
        for (int i = 0; i < 16; ++i) acc[i] = 0.f;
#pragma unroll
        for (int s = 0; s < 4; ++s) { const bf16x8 a = *(const LAS bf16x8*)(VT + (32 * vt + r) * TPB + (16 * s + 8 * h2) * 2), bb = *(const LAS bf16x8*)(KtT + (32 * kt + r) * TPB + (16 * s + 8 * h2) * 2);
            acc = MFMA32(a, bb, acc); }
#pragma unroll
        for (int i = 0; i < 16; ++i) So[(32 * vt + crow(i, h2)) * 128 + 32 * kt + r] = acc[i];
    }
    __syncthreads();
}
__device__ __forceinline__ void hgrn_out_item(const Ctx& C, LAS unsigned char* lds, int item) {
    const int c = item & 63, h = (item >> 6) & 3, b = item >> 8;
    const size_t row0 = (size_t)(b * SEQ + c * 64);
    const bf16* Z = C.HID + row0 * ZP;
    LAS unsigned char* Qt = lds; LAS unsigned char* Kt2 = lds + 64 * KQB; LAS unsigned char* VT = lds + 2 * 64 * KQB; LAS unsigned char* ST = VT + 128 * TPB;
    LAS float* segs = (LAS float*)(ST + 128 * KQB); LAS float* part = segs + 512;
    const int seg = C.tid >> 7, k = C.tid & 127;
    const float l0 = C.in[9][h * 128 + k], l1 = C.in[9][512 + h * 128 + k], lb = sigmoidf_(l0 - l1);
    float G[16], kk[16], qq[16]; float cum = 0.f; unsigned vraw[16], fraw[16], qraw[16]; f32x4 s4[8];
    const float* Ss = C.SLOC + (size_t)item * 16384;
#pragma unroll
    for (int e = 0; e < 16; ++e) { const bf16* zr = Z + (size_t)(seg * 16 + e) * ZP + h * 128 + k; fraw[e] = zr[ZHF]; vraw[e] = zr[ZHI]; qraw[e] = zr[ZHQ]; }
#pragma unroll
    for (int j = 0; j < 8; ++j) s4[j] = *(const f32x4*)(Ss + (j * NTHR + C.tid) * 4);
    __builtin_amdgcn_sched_barrier(0);
#pragma unroll
    for (int e = 0; e < 16; ++e) { const float hf = bf2f(fraw[e]); qq[e] = siluf_(bf2f(qraw[e]));
        const float sg = sigmoidf_(hf), f = lb + (1.f - lb) * sg; cum += __logf(f); G[e] = cum; kk[e] = 1.f - f; }
    segs[seg * 128 + k] = cum;
    {
#pragma unroll
        for (int j = 0; j < 8; ++j) { const int e = (j * NTHR + C.tid) * 4, v = e >> 7, k4 = e & 127;
            v2u w; w.x = cvtpk(s4[j].x, s4[j].y); w.y = cvtpk(s4[j].z, s4[j].w); *(LAS v2u*)(ST + v * KQB + k4 * 2) = w; }
    }
    __syncthreads();
    float off = 0.f;
#pragma unroll
    for (int s = 0; s < 4; ++s) { const float v = segs[s * 128 + k]; if (s < seg) off += v; }
    {
        unsigned vw[8];
#pragma unroll
        for (int e = 0; e < 16; ++e) { const float g = off + G[e]; const int t = seg * 16 + e;
            *(LAS unsigned short*)(Qt + t * KQB + k * 2) = (unsigned short)(cvtpk(qq[e] * __expf(g), 0.f) & 0xffffu);
            *(LAS unsigned short*)(Kt2 + t * KQB + k * 2) = (unsigned short)(cvtpk(kk[e] * __expf(-g), 0.f) & 0xffffu); }
#pragma unroll
        for (int e = 0; e < 8; ++e) vw[e] = vraw[2 * e] | (vraw[2 * e + 1] << 16);
        *(LAS v4u*)(VT + k * TPB + seg * 32) = (v4u){vw[0], vw[1], vw[2], vw[3]}; *(LAS v4u*)(VT + k * TPB + seg * 32 + 16) = (v4u){vw[4], vw[5], vw[6], vw[7]};
    }
    __syncthreads();
    const int r = C.lane & 31, h2 = C.lane >> 5, vt = C.wave >> 1, tt = C.wave & 1;
    const int t = 32 * tt + r;
    const bf16* zg = Z + (size_t)t * ZP + ZHG + h * 128 + 32 * vt + 4 * h2;
    const float* gn = C.in[10] + 32 * vt + 4 * h2;
    v2u gwp[4]; f32x4 ggp[4];
#pragma unroll
    for (int i4 = 0; i4 < 4; ++i4) { gwp[i4] = *(const v2u*)(zg + 8 * i4); ggp[i4] = *(const f32x4*)(gn + 8 * i4); }
    bf16x8 qf[8];
#pragma unroll
    for (int ks = 0; ks < 8; ++ks) qf[ks] = *(const LAS bf16x8*)(Qt + (32 * tt + r) * KQB + (16 * ks + 8 * h2) * 2);
    f32x16 acc;
#pragma unroll
    for (int i = 0; i < 16; ++i) acc[i] = 0.f;
#pragma unroll
    for (int ks = 0; ks < 8; ++ks) { const bf16x8 a = *(const LAS bf16x8*)(ST + (32 * vt + r) * KQB + (16 * ks + 8 * h2) * 2); acc = MFMA32(a, qf[ks], acc); }
#pragma unroll
    for (int st = 0; st < 2; ++st) {
        if (st <= tt) {
            f32x16 X;
#pragma unroll
            for (int i = 0; i < 16; ++i) X[i] = 0.f;
#pragma unroll
            for (int ks = 0; ks < 8; ++ks) { const bf16x8 a = *(const LAS bf16x8*)(Kt2 + (32 * st + r) * KQB + (16 * ks + 8 * h2) * 2); X = MFMA32(a, qf[ks], X); }
#pragma unroll
            for (int i = 0; i < 16; ++i) { const int s = 32 * st + crow(i, h2), t = 32 * tt + r; X[i] = (s <= t) ? X[i] : 0.f; }
#pragma unroll
            for (int s2 = 0; s2 < 2; ++s2) {
                v4u pw; pw.x = cvtpk(X[8 * s2 + 0], X[8 * s2 + 1]); pw.y = cvtpk(X[8 * s2 + 2], X[8 * s2 + 3]); pw.z = cvtpk(X[8 * s2 + 4], X[8 * s2 + 5]); pw.w = cvtpk(X[8 * s2 + 6], X[8 * s2 + 7]);
                const bf16x8 pb = __builtin_bit_cast(bf16x8, pw);
                const LAS unsigned char* vp = VT + (32 * vt + r) * TPB + (32 * st + 16 * s2 + 4 * h2) * 2;
                const s16x4 l4 = *(const LAS s16x4*)vp, h4 = *(const LAS s16x4*)(vp + 16);
                acc = MFMA32(__builtin_shufflevector(l4, h4, 0, 1, 2, 3, 4, 5, 6, 7), pb, acc);
            }
        }
    }
    float ssq = 0.f;
#pragma unroll
    for (int i = 0; i < 16; ++i) ssq += acc[i] * acc[i];
    ssq += __shfl_xor(ssq, 32);
    if (h2 == 0) part[vt * 64 + 32 * tt + r] = ssq;
    __syncthreads();
    const float tot = (part[t] + part[64 + t]) + (part[128 + t] + part[192 + t]);
    const float rinv = rsqrtf(tot * (1.f / 128.f) + EPS);
    bf16* mo = C.MIX + (row0 + t) * D + 512 + h * 128 + 32 * vt + 4 * h2;
#pragma unroll
    for (int i4 = 0; i4 < 4; ++i4) { const v2u gw = gwp[i4]; const f32x4 gg = ggp[i4];
        const float o0 = acc[4 * i4] * rinv * gg.x * siluf_(bf2f(gw.x & 0xffffu)), o1 = acc[4 * i4 + 1] * rinv * gg.y * siluf_(bf2f(gw.x >> 16));
        const float o2 = acc[4 * i4 + 2] * rinv * gg.z * siluf_(bf2f(gw.y & 0xffffu)), o3 = acc[4 * i4 + 3] * rinv * gg.w * siluf_(bf2f(gw.y >> 16));
        v2u w; w.x = cvtpk(o0, o1); w.y = cvtpk(o2, o3); *(v2u*)(mo + 8 * i4) = w; }
    __syncthreads();
}
__device__ __forceinline__ void hgrn_sample_item(const Ctx& C, LAS unsigned char* lds, int item) {
    const int h = item & 3, b = item >> 2;
    LAS float* fA = (LAS float*)lds; LAS float* kA = fA + 1024; LAS float* qA = kA + 1024; LAS float* vA = qA + 1024; LAS float* gA = vA + 1024; LAS float* part = gA + 1024;
    const int v4 = C.tid & 31, kg = C.tid >> 5;
    const float* S0 = C.in[4] + ((size_t)(b * 4 + h) * 128 + kg * 8) * 128 + v4 * 4;
    f32x4 S[8];
#pragma unroll
    for (int i = 0; i < 8; ++i) S[i] = *(const f32x4*)(S0 + i * 128);
    {
        const int t = C.tid >> 6, c2 = (C.tid & 63) * 2; const bf16* zr = C.HID + (size_t)(TP + b * DL + t) * ZP + h * 128 + c2;
        const unsigned wq = *(const unsigned*)(zr + ZHQ), wf = *(const unsigned*)(zr + ZHF), wi = *(const unsigned*)(zr + ZHI), wg = *(const unsigned*)(zr + ZHG);
#pragma unroll
        for (int e = 0; e < 2; ++e) { const int k = c2 + e; const float l0 = C.in[9][h * 128 + k], l1 = C.in[9][512 + h * 128 + k], lb = sigmoidf_(l0 - l1);
            const float hq = bf2f(e ? (wq >> 16) : (wq & 0xffffu)), hf = bf2f(e ? (wf >> 16) : (wf & 0xffffu)), hi = bf2f(e ? (wi >> 16) : (wi & 0xffffu)), hg = bf2f(e ? (wg >> 16) : (wg & 0xffffu));
            const float f = lb + (1.f - lb) * sigmoidf_(hf);
            fA[t * 128 + k] = f; kA[t * 128 + k] = 1.f - f; qA[t * 128 + k] = siluf_(hq); vA[t * 128 + k] = hi; gA[t * 128 + k] = siluf_(hg); }
    }
    __syncthreads();
#pragma unroll
    for (int t = 0; t < 8; ++t) {
        const f32x4 vv = *(const LAS f32x4*)(vA + t * 128 + v4 * 4); f32x4 po = {0.f, 0.f, 0.f, 0.f};
#pragma unroll
        for (int i = 0; i < 8; ++i) { const int k = kg * 8 + i; const float f = fA[t * 128 + k], kk = kA[t * 128 + k], q = qA[t * 128 + k]; S[i] = S[i] * f + vv * kk; po += S[i] * q; }
        *(LAS f32x4*)(part + (t * 16 + kg) * 128 + v4 * 4) = po;
    }
    float* So = C.out + OFF_SS + ((size_t)(b * 4 + h) * 128 + kg * 8) * 128 + v4 * 4;
#pragma unroll
    for (int i = 0; i < 8; ++i) *(f32x4*)(So + i * 128) = S[i];
    __syncthreads();
    {
        const int t = C.tid >> 6, c2 = (C.tid & 63) * 2; float o0 = 0.f, o1 = 0.f;
#pragma unroll
        for (int j = 0; j < 16; ++j) { const f32x2 p = *(const LAS f32x2*)(part + (t * 16 + j) * 128 + c2); o0 += p.x; o1 += p.y; }
        const float rinv = rsqrtf(wave_sum(o0 * o0 + o1 * o1) * (1.f / 128.f) + EPS);
        const float g0 = C.in[10][c2], g1 = C.in[10][c2 + 1];
        *(unsigned*)(C.MIX + (size_t)(TP + b * DL + t) * D + 512 + h * 128 + c2) = cvtpk(o0 * rinv * g0 * gA[t * 128 + c2], o1 * rinv * g1 * gA[t * 128 + c2 + 1]);
    }
    __syncthreads();
}

struct Args { const float* in[22]; float* out; unsigned char* ws; int ph_lo, ph_hi; };

__global__ void __launch_bounds__(NTHR, 2) fwd(Args args) {
    extern __shared__ __attribute__((aligned(16))) unsigned char lds_raw[];
    LAS unsigned char* lds = (LAS unsigned char*)lds_raw;
    Ctx C;
#pragma unroll
    for (int i = 0; i < 22; ++i) C.in[i] = args.in[i];
    C.out = args.out; C.ws = args.ws;
    C.XN = (bf16*)(args.ws + WS_XN); C.HID = (bf16*)(args.ws + WS_HID); C.MIX = C.XN; C.Y = (float*)(args.ws + WS_Y); C.SLOC = C.Y; C.DEC = (float*)(args.ws + WS_DEC);
    C.tid = threadIdx.x; C.lane = C.tid & 63; C.wave = __builtin_amdgcn_readfirstlane(C.tid >> 6);
    bf16* Wgu1 = (bf16*)(args.ws + WS_WGU1); bf16* Wd1 = (bf16*)(args.ws + WS_WD1); bf16* Win = (bf16*)(args.ws + WS_WIN); bf16* Wout = (bf16*)(args.ws + WS_WOUT);
    bf16* Wgu2 = (bf16*)(args.ws + WS_WGU2); bf16* Wd2 = (bf16*)(args.ws + WS_WD2);
    const int G = gridDim.x, bid = blockIdx.x, gw = bid * NWAVES + C.wave, NGW = G * NWAVES;
    const int lo = args.ph_lo, hi = args.ph_hi;
    cg::grid_group grid = cg::this_grid();
    float* PART = (float*)(args.ws + WS_PART);
    volatile LAS unsigned* MISC = (volatile LAS unsigned*)(lds + MISC_OFF);
    if (C.tid < 16) MISC[C.tid] = 0u;
    __syncthreads();
    XcdBarrier bar; bar.bar = (unsigned*)args.ws + CW_BAR; bar.x = 0; bar.st = nullptr;
    if (hi - lo > 1) bar = xcd_barrier_post((unsigned*)args.ws + CW_BAR, MISC + 8);
#define IN(k) (lo <= (k) && (k) < hi)
#define SEAM(k) do { if (IN(k) && IN((k) + 1)) { if ((k) == 0) grid.sync(); else xcd_barrier(bar); } } while (0)
#define YROW(m) ((m) < TP ? C.Y + (size_t)(m) * D : PART + (size_t)((m) - TP) * D)
#define NPARTS(m) ((m) < TP ? 1 : 4)
#define XROW(m) ((m) < TP ? C.in[0] + (size_t)(m) * D : C.in[1] + (size_t)((m) - TP) * D)

    if (IN(0)) {
        LAS float* scr = (LAS float*)(lds + C.wave * 16640);
        constexpr int I_GU = 16 * 88, I_DN = 44 * 16, I_IN = 16 * 44, I_OUT = 16 * 16, NIT = 2 * I_GU + 2 * I_DN + I_IN + I_OUT;
        for (int it = gw; it < NIT; it += NGW) {
            int r = it;
            if (r < I_GU) { transpose_item(C.in[12], D, 2 * FF, Wgu1, FF, 2, scr, r, C.lane); continue; } r -= I_GU;
            if (r < I_GU) { transpose_item(C.in[14], D, 2 * FF, Wgu2, FF, 2, scr, r, C.lane); continue; } r -= I_GU;
            if (r < I_DN) { transpose_item(C.in[13], FF, D, Wd1, D, 1, scr, r, C.lane); continue; } r -= I_DN;
            if (r < I_DN) { transpose_item(C.in[15], FF, D, Wd2, D, 1, scr, r, C.lane); continue; } r -= I_DN;
            if (r < I_IN) { transpose_item(C.in[5], D, ZP, Win, ZP, 1, scr, r, C.lane); continue; } r -= I_IN;
            transpose_item(C.in[11], D, D, Wout, D, 1, scr, r, C.lane);
        }
        for (int m = gw; m < T; m += NGW) rms_row_bf16(XROW(m), C.in[16], C.XN + (size_t)m * D, C.lane);
    }
    SEAM(0);
    if (IN(1)) { pg8::Gemm g{C.XN, Wgu1, T, 2 * FF, D}; pg8::StaticOrder S; S.init(T, 2 * FF, G, bid, D); EpiSwiGLU E{C.HID, FF};
        pg8::gemm_phase<EpiSwiGLU, pg8::StaticOrder, true, true>(lds, g, S, E); }
    SEAM(1);
    if (IN(2)) { pg8::Gemm g{C.HID, Wd1, T, D, FF}; pg8::SplitOrder S; S.init(G, bid, FF); EpiF32 E{C.Y, D, PART};
        pg8::gemm_phase<EpiF32, pg8::SplitOrder, true, true>(lds, g, S, E); }
    SEAM(2);
    if (IN(3)) { for (int m = gw; m < T; m += NGW) row_update(XROW(m), YROW(m), NPARTS(m), C.in[17], 0.5f, C.out + (size_t)m * D, C.in[18], C.XN + (size_t)m * D, C.lane); }
    SEAM(3);
    if (IN(4)) { pg8::Gemm g{C.XN, Win, T, ZP, D}; pg8::StaticOrder S; S.init(T, ZP, G, bid, D); pg8::EpiBf16<0> E{C.HID, ZP, C.in[6], 0, 0, 1.f};
        pg8::gemm_phase<pg8::EpiBf16<0>, pg8::StaticOrder, true, true>(lds, g, S, E); }
    SEAM(4);
    if (IN(5)) {
        for (int it = bid; it < 2048; it += G) {
            if (it < 1024) hgrn_local_item(C, lds, it);
            else if (it < 1280) attn_prompt_item(C, lds, it - 1024);
            else if (it < 1792) hgrn_sample_item(C, lds, it - 1280);
            else attn_sample_item(C, lds, it - 1792);
        }
    }
    SEAM(5);
    if (IN(6)) {
        for (int idx = bid * NTHR + C.tid; idx < 16 * 8192; idx += G * NTHR) {
            const int bh = idx >> 13, e2 = idx & 8191, v = e2 >> 6, k2 = (e2 & 63) * 2;
            f32x2 S = {0.f, 0.f};
            float* p = C.SLOC + (size_t)bh * 64 * 16384 + v * 128 + k2; const float* dp = C.DEC + (size_t)bh * 64 * 128 + k2;
#pragma unroll 1
            for (int c0 = 0; c0 < 64; c0 += 16) { f32x2 tmp[16], d[16];
#pragma unroll
                for (int c = 0; c < 16; ++c) { tmp[c] = *(const f32x2*)(p + (size_t)(c0 + c) * 16384); d[c] = *(const f32x2*)(dp + (c0 + c) * 128); }
                __builtin_amdgcn_sched_barrier(0);
#pragma unroll
                for (int c = 0; c < 16; ++c) { *(f32x2*)(p + (size_t)(c0 + c) * 16384) = S; S = d[c] * S + tmp[c]; } }
            float* so = C.out + OFF_SP + (size_t)bh * 16384 + (size_t)k2 * 128 + v; so[0] = S.x; so[128] = S.y;
        }
        for (int m = gw; m < T; m += NGW) {
            bf16* ar = C.MIX + (size_t)m * D + C.lane * 8; const v4u w = *(const v4u*)ar; float x[8]; float s = 0.f;
#pragma unroll
            for (int j = 0; j < 4; ++j) { x[2 * j] = bf2f(w[j] & 0xffffu); x[2 * j + 1] = bf2f(w[j] >> 16); s += x[2 * j] * x[2 * j] + x[2 * j + 1] * x[2 * j + 1]; }
            const float r = rsqrtf(wave_sum(s) * (1.f / 512.f) + EPS); const float* gp = C.in[8] + C.lane * 8; const f32x4 g0 = *(const f32x4*)gp, g1 = *(const f32x4*)(gp + 4);
            v4u o; o.x = cvtpk(x[0] * r * g0.x, x[1] * r * g0.y); o.y = cvtpk(x[2] * r * g0.z, x[3] * r * g0.w); o.z = cvtpk(x[4] * r * g1.x, x[5] * r * g1.y); o.w = cvtpk(x[6] * r * g1.z, x[7] * r * g1.w);
            *(v4u*)ar = o;
        }
    }
    SEAM(6);
    if (IN(7)) { for (int it = bid; it < 1024; it += G) hgrn_out_item(C, lds, it); }
    SEAM(7);
    if (IN(8)) { pg8::Gemm g{C.MIX, Wout, T, D, D}; pg8::SplitOrder S; S.init(G, bid, D); EpiF32 E{C.Y, D, PART};
        pg8::gemm_phase<EpiF32, pg8::SplitOrder, true, true>(lds, g, S, E); }
    SEAM(8);
    if (IN(9)) { for (int m = gw; m < T; m += NGW) row_update(C.out + (size_t)m * D, YROW(m), NPARTS(m), C.in[19], 1.0f, C.out + (size_t)m * D, C.in[20], C.XN + (size_t)m * D, C.lane); }
    SEAM(9);
    if (IN(10)) { pg8::Gemm g{C.XN, Wgu2, T, 2 * FF, D}; pg8::StaticOrder S; S.init(T, 2 * FF, G, bid, D); EpiSwiGLU E{C.HID, FF};
        pg8::gemm_phase<EpiSwiGLU, pg8::StaticOrder, true, true>(lds, g, S, E); }
    SEAM(10);
    if (IN(11)) { pg8::Gemm g{C.HID, Wd2, T, D, FF}; pg8::SplitOrder S; S.init(G, bid, FF); EpiF32 E{C.Y, D, PART};
        pg8::gemm_phase<EpiF32, pg8::SplitOrder, true, true>(lds, g, S, E); }
    SEAM(11);
    if (IN(12)) { for (int m = gw; m < T; m += NGW) row_update(C.out + (size_t)m * D, YROW(m), NPARTS(m), C.in[21], 0.5f, C.out + (size_t)m * D, nullptr, nullptr, C.lane); }
#undef IN
#undef SEAM
#undef XROW
#undef YROW
#undef NPARTS
}

extern "C" void kernel_launch(void* const* d_in, const int* in_sizes, int n_in, void* d_out, int out_size, void* d_ws, size_t ws_size, hipStream_t stream) {
    static int grid = 0;
    if (grid == 0) {
        if (n_in != 22 || ws_size < WS_END) { fprintf(stderr, "kernel_launch: unexpected inputs (n_in %d, ws %zu)\n", n_in, ws_size); grid = -1; return; }
        int dev = 0, cus = 0, per_cu = 0;
        (void)hipGetDevice(&dev); (void)hipDeviceGetAttribute(&cus, hipDeviceAttributeMultiprocessorCount, dev);
        if (hipFuncSetAttribute((const void*)fwd, hipFuncAttributeMaxDynamicSharedMemorySize, LDS_BYTES) != hipSuccess) { fprintf(stderr, "kernel_launch: hipFuncSetAttribute failed\n"); grid = -1; return; }
        if (hipOccupancyMaxActiveBlocksPerMultiprocessor(&per_cu, (const void*)fwd, NTHR, LDS_BYTES) != hipSuccess || per_cu < 1) per_cu = 1;
        (void)hipGetLastError();
        grid = cus * per_cu;
    }
    if (grid < 0) return;
    if (hipMemsetAsync(d_ws, 0, CTL_ZERO_BYTES, stream) != hipSuccess) { fprintf(stderr, "kernel_launch: memset failed\n"); return; }
    Args a{};
    for (int i = 0; i < 22; ++i) a.in[i] = (const float*)d_in[i];
    a.out = (float*)d_out; a.ws = (unsigned char*)d_ws;
#if MK_N_LAUNCHES == 1
    a.ph_lo = 0; a.ph_hi = NPH;
    void* kargs[] = {&a};
    hipError_t e = hipLaunchCooperativeKernel((const void*)fwd, dim3(grid), dim3(NTHR), kargs, LDS_BYTES, stream);
    if (e != hipSuccess) fprintf(stderr, "cooperative launch failed: %s (grid %d)\n", hipGetErrorString(e), grid);
#else
    for (int p = 0; p < NPH; ++p) { a.ph_lo = p; a.ph_hi = p + 1; hipLaunchKernelGGL(fwd, dim3(grid), dim3(NTHR), LDS_BYTES, stream, a); }
#endif
}
```
